# Optimizing an MI355X kernel written in HIP

```python
import math
import jax, jax.numpy as jnp
from jax import lax
import numpy as np

D_MODEL = 1024
BATCH = 8
SEQ = 2048
DEPTH = 1

PLE_DIM = 256
Q_BLOCK = 128

NSA_HEADS = 8
NSA_GROUPS = 2
NSA_HPG = NSA_HEADS // NSA_GROUPS
HEAD_DIM = 64
CMP_BLOCK = 32
CMP_STRIDE = 16
CMP_HIDDEN = 256
SEL_BLOCK = 64
SEL_TOPK = 8
WINDOW = 512
SEL_FORCE = 1.0e4

DIFF_HEADS = 4
DIFF_DH = 64
DIFF_VDIM = 2 * DIFF_DH

PEER_HEADS = 8
PEER_NKEYS = 128
PEER_NEXPERTS = PEER_NKEYS * PEER_NKEYS
PEER_DKEY = 256
PEER_TOPK = 16
PEER_CHUNK = 128

NSA_WIDTH = NSA_HEADS * HEAD_DIM
NSA_KV = NSA_GROUPS * HEAD_DIM
DIFF_QK = DIFF_HEADS * DIFF_DH
DIFF_WIDTH = DIFF_HEADS * DIFF_VDIM
IN_SPLITS = (NSA_WIDTH, 6 * NSA_KV, 3 * NSA_HEADS, 2 * DIFF_QK, 2 * DIFF_QK, DIFF_WIDTH, D_MODEL, D_MODEL)
IN_COLS = NSA_WIDTH + 6 * NSA_KV + 3 * NSA_HEADS + 4 * DIFF_QK + DIFF_WIDTH + 2 * D_MODEL

DEEPNORM_ALPHA = (2.0 * DEPTH) ** 0.25
DEEPNORM_BETA = (8.0 * DEPTH) ** -0.25
NEG = -1.0e30

kernel_name = 'hybrid_nsa_diffattn_peer_block'


def alibi_slopes(n):
    return jnp.exp2(-8.0 * jnp.arange(1, n + 1, dtype=jnp.float32) / n)


def layer_norm(x, g, b, eps=1e-5):
    xf = x.astype(jnp.float32)
    mu = jnp.mean(xf, axis=-1, keepdims=True)
    var = jnp.mean(jnp.square(xf - mu), axis=-1, keepdims=True)
    return ((xf - mu) * lax.rsqrt(var + eps) * g.astype(jnp.float32) + b.astype(jnp.float32)).astype(x.dtype)


def masked_softmax(s, mask):
    s = jnp.where(mask, s, NEG)
    m = jnp.max(s, axis=-1, keepdims=True)
    e = jnp.where(mask, jnp.exp(s - m), 0.0)
    return e / jnp.maximum(jnp.sum(e, axis=-1, keepdims=True), 1e-30)


def compress_kv(kv, pos_emb, w1, w2):
    S = kv.shape[2]
    nc = (S - CMP_BLOCK) // CMP_STRIDE + 1
    idx = jnp.arange(nc)[:, None] * CMP_STRIDE + jnp.arange(CMP_BLOCK)[None, :]
    blocks = kv[:, :, idx] + pos_emb
    flat = blocks.reshape(blocks.shape[:3] + (CMP_BLOCK * HEAD_DIM,))
    return jax.nn.gelu(flat @ w1, approximate=False) @ w2


def cmp_to_sel_weights(nc, n_sel):
    c0 = jnp.arange(nc)[:, None] * CMP_STRIDE
    s0 = jnp.arange(n_sel)[None, :] * SEL_BLOCK
    ov = jnp.minimum(c0 + CMP_BLOCK, s0 + SEL_BLOCK) - jnp.maximum(c0, s0)
    return jnp.clip(ov, 0, None).astype(jnp.float32) / CMP_BLOCK


def token_mixers(h, w_in, cmp_pos_k, cmp_pos_v, cmp_k_w1, cmp_k_w2, cmp_v_w1, cmp_v_w2,
                 lam_q1, lam_k1, lam_q2, lam_k2, diff_norm_g, w_branch_nsa, w_branch_diff, w_out, layer_idx):
    B, S, _ = h.shape
    dt = h.dtype
    f32 = jnp.float32
    nq = S // Q_BLOCK
    proj = h @ w_in
    cuts = np.cumsum(IN_SPLITS)[:-1].tolist()
    q_n, kv_n, g_n, q_d, k_d, v_d, gate_a, gate_b = jnp.split(proj, cuts, axis=-1)

    q_n = q_n.reshape(B, S, NSA_GROUPS, NSA_HPG, HEAD_DIM).transpose(0, 2, 3, 1, 4) * (HEAD_DIM ** -0.5)
    kv_n = kv_n.reshape(B, S, 6, NSA_GROUPS, HEAD_DIM).transpose(2, 0, 3, 1, 4)
    k_c, v_c, k_s, v_s, k_w, v_w = [kv_n[j] for j in range(6)]
    kc = compress_kv(k_c, cmp_pos_k, cmp_k_w1, cmp_k_w2)
    vc = compress_kv(v_c, cmp_pos_v, cmp_v_w1, cmp_v_w2)
    nc = kc.shape[2]
    c_end = jnp.arange(nc) * CMP_STRIDE + (CMP_BLOCK - 1)
    n_sel = S // SEL_BLOCK
    k_sel = min(SEL_TOPK, n_sel)
    sel_w = cmp_to_sel_weights(nc, n_sel)
    ks_blk = k_s.reshape(B, NSA_GROUPS, n_sel, SEL_BLOCK, HEAD_DIM)
    vs_blk = v_s.reshape(B, NSA_GROUPS, n_sel, SEL_BLOCK, HEAD_DIM)
    kw_pad = jnp.pad(k_w, ((0, 0), (0, 0), (WINDOW, 0), (0, 0)))
    vw_pad = jnp.pad(v_w, ((0, 0), (0, 0), (WINDOW, 0), (0, 0)))
    gates_n = jax.nn.sigmoid(g_n.reshape(B, nq, Q_BLOCK, NSA_GROUPS, NSA_HPG, 3)).transpose(1, 0, 3, 4, 2, 5)
    slopes_n = alibi_slopes(NSA_HEADS).reshape(NSA_GROUPS, NSA_HPG)[None, :, :, None, None]
    q_n_blk = jnp.moveaxis(q_n.reshape(B, NSA_GROUPS, NSA_HPG, nq, Q_BLOCK, HEAD_DIM), 3, 0)
    bi = jnp.arange(B)[:, None, None, None]
    gi = jnp.arange(NSA_GROUPS)[None, :, None, None]

    q_d = q_d.reshape(B, S, 2, DIFF_HEADS, DIFF_DH) * (DIFF_DH ** -0.5)
    k_d = k_d.reshape(B, S, 2, DIFF_HEADS, DIFF_DH)
    q1_blk = jnp.moveaxis(q_d[:, :, 0].transpose(0, 2, 1, 3).reshape(B, DIFF_HEADS, nq, Q_BLOCK, DIFF_DH), 2, 0)
    q2_blk = jnp.moveaxis(q_d[:, :, 1].transpose(0, 2, 1, 3).reshape(B, DIFF_HEADS, nq, Q_BLOCK, DIFF_DH), 2, 0)
    k1 = k_d[:, :, 0].transpose(0, 2, 1, 3)
    k2 = k_d[:, :, 1].transpose(0, 2, 1, 3)
    v_d = v_d.reshape(B, S, DIFF_HEADS, DIFF_VDIM).transpose(0, 2, 1, 3)
    lam_init = 0.8 - 0.6 * math.exp(-0.3 * layer_idx)
    lam = (jnp.exp(jnp.sum(lam_q1.astype(f32) * lam_k1.astype(f32)))
           - jnp.exp(jnp.sum(lam_q2.astype(f32) * lam_k2.astype(f32))) + lam_init)
    slopes_d = alibi_slopes(DIFF_HEADS)[None, :, None, None]
    key_pos = jnp.arange(S)
    norm_g = diff_norm_g.astype(f32)

    def block(args):
        i, qn, gn, qa, qb = args
        t = i * Q_BLOCK + jnp.arange(Q_BLOCK)
        dist_c = (t[:, None] - c_end[None, :]).astype(f32)
        s = jnp.einsum('bghqd,bgcd->bghqc', qn, kc).astype(f32) - slopes_n * dist_c
        p_cmp = masked_softmax(s, dist_c >= 0)
        o_cmp = jnp.einsum('bghqc,bgcd->bghqd', p_cmp.astype(dt), vc)
        imp = jnp.einsum('bghqc,cj->bgqj', p_cmp, sel_w)
        jb = jnp.arange(n_sel)[None, :]
        cur = (t // SEL_BLOCK)[:, None]
        allowed = jb * SEL_BLOCK <= t[:, None]
        forced = (jb == 0) | (jb == cur) | (jb == cur - 1)
        score = jnp.where(forced, SEL_FORCE, jnp.where(allowed, imp, -SEL_FORCE))
        _, sel = lax.top_k(score, k_sel)
        L = k_sel * SEL_BLOCK
        ks = ks_blk[bi, gi, sel].reshape(B, NSA_GROUPS, Q_BLOCK, L, HEAD_DIM)
        vs = vs_blk[bi, gi, sel].reshape(B, NSA_GROUPS, Q_BLOCK, L, HEAD_DIM)
        pos = (sel[..., None] * SEL_BLOCK + jnp.arange(SEL_BLOCK)).reshape(B, NSA_GROUPS, Q_BLOCK, L)
        dist_s = (t[None, None, :, None] - pos).astype(f32)[:, :, None]
        s = jnp.einsum('bghqd,bgqld->bghql', qn, ks).astype(f32) - slopes_n * dist_s
        o_slc = jnp.einsum('bghql,bgqld->bghqd', masked_softmax(s, dist_s >= 0).astype(dt), vs)
        kw = lax.dynamic_slice_in_dim(kw_pad, i * Q_BLOCK, WINDOW + Q_BLOCK, axis=2)
        vw = lax.dynamic_slice_in_dim(vw_pad, i * Q_BLOCK, WINDOW + Q_BLOCK, axis=2)
        wpos = i * Q_BLOCK - WINDOW + jnp.arange(WINDOW + Q_BLOCK)
        dist_w = t[:, None] - wpos[None, :]
        mask_w = (dist_w >= 0) & (dist_w < WINDOW) & (wpos[None, :] >= 0)
        s = jnp.einsum('bghqd,bgld->bghql', qn, kw).astype(f32) - slopes_n * dist_w.astype(f32)
        o_win = jnp.einsum('bghql,bgld->bghqd', masked_softmax(s, mask_w).astype(dt), vw)
        o_nsa = gn[..., 0:1] * o_cmp + gn[..., 1:2] * o_slc + gn[..., 2:3] * o_win
        o_nsa = o_nsa.transpose(0, 3, 1, 2, 4).reshape(B, Q_BLOCK, NSA_WIDTH)
        dist_d = (t[:, None] - key_pos[None, :]).astype(f32)
        mask_d = dist_d >= 0
        bias = -slopes_d * dist_d
        a1 = masked_softmax(jnp.einsum('bhqd,bhkd->bhqk', qa, k1).astype(f32) + bias, mask_d)
        a2 = masked_softmax(jnp.einsum('bhqd,bhkd->bhqk', qb, k2).astype(f32) + bias, mask_d)
        o = jnp.einsum('bhqk,bhkv->bhqv', (a1 - lam * a2).astype(dt), v_d).astype(f32)
        o = o * lax.rsqrt(jnp.mean(o * o, axis=-1, keepdims=True) + 1e-5) * norm_g * (1.0 - lam_init)
        o_diff = o.astype(dt).transpose(0, 2, 1, 3).reshape(B, Q_BLOCK, DIFF_WIDTH)
        return o_nsa, o_diff

    o_nsa, o_diff = lax.map(block, (jnp.arange(nq), q_n_blk, gates_n, q1_blk, q2_blk))
    o_nsa = jnp.moveaxis(o_nsa, 0, 1).reshape(B, S, NSA_WIDTH)
    o_diff = jnp.moveaxis(o_diff, 0, 1).reshape(B, S, DIFF_WIDTH)
    merged = (jax.nn.sigmoid(gate_a) * (o_nsa @ w_branch_nsa)
              + jax.nn.sigmoid(gate_b) * (o_diff @ w_branch_diff))
    return merged @ w_out


def peer_ffn(h, wq, subkeys1, subkeys2, u_tab, v_tab):
    B, S, D = h.shape
    f32 = jnp.float32
    q = (h @ wq).reshape(B, S, PEER_HEADS, 2, PEER_DKEY // 2)
    s1 = jnp.einsum('bshc,kc->bshk', q[:, :, :, 0], subkeys1).astype(f32)
    s2 = jnp.einsum('bshc,kc->bshk', q[:, :, :, 1], subkeys2).astype(f32)
    v1, i1 = lax.top_k(s1, PEER_TOPK)
    v2, i2 = lax.top_k(s2, PEER_TOPK)
    cand = (v1[..., :, None] + v2[..., None, :]).reshape(B, S, PEER_HEADS, PEER_TOPK * PEER_TOPK)
    cid = (i1[..., :, None] * PEER_NKEYS + i2[..., None, :]).reshape(B, S, PEER_HEADS, PEER_TOPK * PEER_TOPK)
    sc, pick = lax.top_k(cand, PEER_TOPK)
    eid = jnp.take_along_axis(cid, pick, axis=-1)
    g = jax.nn.softmax(sc, axis=-1).astype(h.dtype)
    n_chunk = (B * S) // PEER_CHUNK
    xs = h.reshape(n_chunk, PEER_CHUNK, D)
    es = eid.reshape(n_chunk, PEER_CHUNK, PEER_HEADS, PEER_TOPK)
    gs = g.reshape(n_chunk, PEER_CHUNK, PEER_HEADS, PEER_TOPK)

    def chunk(args):
        xc, ec, gc = args
        u = u_tab[ec]
        v = v_tab[ec]
        a = jax.nn.gelu(jnp.einsum('cd,chkd->chk', xc, u), approximate=False)
        return jnp.einsum('chk,chkd->cd', gc * a, v)

    return lax.map(chunk, (xs, es, gs)).reshape(B, S, D)


def setup_inputs(seed: int = 0) -> dict:
    key = jax.random.key(seed)
    ks = jax.random.split(key, 32)
    f32 = jnp.float32
    L = DEPTH

    def nrm(k, shape, scale):
        return jax.random.normal(k, shape, f32) * scale

    return {
        'x': nrm(ks[0], (BATCH, SEQ, D_MODEL), 1.0),
        'p': nrm(ks[1], (DEPTH, BATCH, SEQ, PLE_DIM), 1.0),
        'w_in': nrm(ks[2], (L, D_MODEL, IN_COLS), D_MODEL ** -0.5),
        'cmp_pos_k': nrm(ks[3], (L, CMP_BLOCK, HEAD_DIM), 0.1),
        'cmp_pos_v': nrm(ks[4], (L, CMP_BLOCK, HEAD_DIM), 0.1),
        'cmp_k_w1': nrm(ks[5], (L, CMP_BLOCK * HEAD_DIM, CMP_HIDDEN), (CMP_BLOCK * HEAD_DIM) ** -0.5),
        'cmp_k_w2': nrm(ks[6], (L, CMP_HIDDEN, HEAD_DIM), CMP_HIDDEN ** -0.5),
        'cmp_v_w1': nrm(ks[7], (L, CMP_BLOCK * HEAD_DIM, CMP_HIDDEN), (CMP_BLOCK * HEAD_DIM) ** -0.5),
        'cmp_v_w2': nrm(ks[8], (L, CMP_HIDDEN, HEAD_DIM), CMP_HIDDEN ** -0.5),
        'lam_q1': nrm(ks[9], (L, DIFF_DH), 0.1),
        'lam_k1': nrm(ks[10], (L, DIFF_DH), 0.1),
        'lam_q2': nrm(ks[11], (L, DIFF_DH), 0.1),
        'lam_k2': nrm(ks[12], (L, DIFF_DH), 0.1),
        'diff_norm_g': 1.0 + nrm(ks[13], (L, DIFF_VDIM), 0.02),
        'w_branch_nsa': nrm(ks[14], (L, NSA_WIDTH, D_MODEL), NSA_WIDTH ** -0.5 * DEEPNORM_BETA),
        'w_branch_diff': nrm(ks[15], (L, DIFF_WIDTH, D_MODEL), DIFF_WIDTH ** -0.5 * DEEPNORM_BETA),
        'w_out': nrm(ks[16], (L, D_MODEL, D_MODEL), D_MODEL ** -0.5 * DEEPNORM_BETA),
        'ln1_g': 1.0 + nrm(ks[17], (L, D_MODEL), 0.02),
        'ln1_b': nrm(ks[18], (L, D_MODEL), 0.02),
        'peer_wq': nrm(ks[19], (L, D_MODEL, PEER_HEADS * PEER_DKEY), D_MODEL ** -0.5),
        'peer_subkeys1': nrm(ks[20], (L, PEER_NKEYS, PEER_DKEY // 2), (PEER_DKEY // 2) ** -0.5),
        'peer_subkeys2': nrm(ks[21], (L, PEER_NKEYS, PEER_DKEY // 2), (PEER_DKEY // 2) ** -0.5),
        'peer_u': nrm(ks[22], (L, PEER_NEXPERTS, D_MODEL), D_MODEL ** -0.5),
        'peer_v': nrm(ks[23], (L, PEER_NEXPERTS, D_MODEL), DEEPNORM_BETA * PEER_HEADS ** -0.5),
        'ln2_g': 1.0 + nrm(ks[24], (L, D_MODEL), 0.02),
        'ln2_b': nrm(ks[25], (L, D_MODEL), 0.02),
        'ple_w_proj': nrm(ks[26], (L, PLE_DIM, D_MODEL), PLE_DIM ** -0.5 * DEEPNORM_BETA),
        'ple_w_gate': nrm(ks[27], (L, D_MODEL, D_MODEL), D_MODEL ** -0.5),
    }


def reference(x, p, w_in, cmp_pos_k, cmp_pos_v, cmp_k_w1, cmp_k_w2, cmp_v_w1, cmp_v_w2,
              lam_q1, lam_k1, lam_q2, lam_k2, diff_norm_g, w_branch_nsa, w_branch_diff, w_out,
              ln1_g, ln1_b, peer_wq, peer_subkeys1, peer_subkeys2, peer_u, peer_v, ln2_g, ln2_b,
              ple_w_proj, ple_w_gate):
    h = x
    for i in range(DEPTH):
        mix = token_mixers(h, w_in[i], cmp_pos_k[i], cmp_pos_v[i], cmp_k_w1[i], cmp_k_w2[i],
                           cmp_v_w1[i], cmp_v_w2[i], lam_q1[i], lam_k1[i], lam_q2[i], lam_k2[i],
                           diff_norm_g[i], w_branch_nsa[i], w_branch_diff[i], w_out[i], i)
        h = layer_norm(DEEPNORM_ALPHA * h + mix, ln1_g[i], ln1_b[i])
        ffn = peer_ffn(h, peer_wq[i], peer_subkeys1[i], peer_subkeys2[i], peer_u[i], peer_v[i])
        h = layer_norm(DEEPNORM_ALPHA * h + ffn, ln2_g[i], ln2_b[i])
        h = h + jax.nn.sigmoid(h @ ple_w_gate[i]) * (p[i] @ ple_w_proj[i])
    return h
```

```cpp
#include <hip/hip_runtime.h>
#include <hip/hip_cooperative_groups.h>
#include <cstdio>
#include <cstring>
namespace cg = cooperative_groups;

#ifndef PHASE_MASK
#define PHASE_MASK 0x7ff
#endif
#ifndef MULTI_LAUNCH
#define MULTI_LAUNCH 1
#endif

#define DI __device__ __forceinline__
typedef short bf16x8 __attribute__((ext_vector_type(8)));
typedef short s16x4 __attribute__((ext_vector_type(4)));
typedef float f32x16 __attribute__((ext_vector_type(16)));
typedef float f32x4 __attribute__((ext_vector_type(4)));
typedef float f32x2 __attribute__((ext_vector_type(2)));
typedef unsigned u32x4 __attribute__((ext_vector_type(4)));
typedef unsigned u32x2 __attribute__((ext_vector_type(2)));
typedef __bf16 bf2_t __attribute__((ext_vector_type(2)));
typedef unsigned short bf16_t;

#define MFMA(a, b, c) __builtin_amdgcn_mfma_f32_32x32x16_bf16((a), (b), (c), 0, 0, 0)

constexpr int T = 16384, SEQ = 2048, DM = 1024;
constexpr int NTHR = 512;
constexpr int PJ = 2176;
constexpr int NPHASE = 11;
constexpr size_t MiB = 1u << 20;
constexpr size_t WS_WINR = 0, WS_WGATE = 6 * MiB, WS_WBN = 10 * MiB, WS_WBD = 11 * MiB, WS_WOUT = 12 * MiB, WS_WQ = 14 * MiB,
                 WS_WPG = 18 * MiB, WS_WPP = 20 * MiB, WS_CW1K = 21 * MiB, WS_CW1V = 22 * MiB, WS_SMALL = 23 * MiB,
                 WS_XB = 24 * MiB, WS_R = 56 * MiB;
constexpr size_t SM_CW2K = WS_SMALL, SM_CW2V = WS_SMALL + 32768, SM_SK1 = WS_SMALL + 65536, SM_SK2 = WS_SMALL + 98304,
                 SM_CBIAS = WS_SMALL + 131072  , SM_LAM = SM_CBIAS + 32768;
constexpr size_t R_PROJ = WS_R, R_VT = WS_R + 68 * MiB, R_HID = WS_R + 92 * MiB, R_KC = WS_R + 94 * MiB, R_VCT = R_KC + 262144,
                 R_ONSA = WS_R + 95 * MiB, R_ODIFF = WS_R + 111 * MiB;
constexpr size_t R_MERGED = WS_R, R_UB = WS_R + 32 * MiB, R_VB = WS_R + 64 * MiB, R_EID = WS_R + 96 * MiB, R_GW = WS_R + 104 * MiB;
constexpr int LDS_BYTES = 131072;
constexpr float LN_ALPHA = 1.189207115f;
constexpr float NEGBIG = -1.0e30f;

struct TJob { const float* src; bf16_t* dst; int ld, col0, ncols, npad, K, tile0; };
constexpr int MAXJOBS = 24;
struct Params {
  const float* in[28];
  float* out;
  unsigned char* ws;
  TJob jobs[MAXJOBS];
  int njobs, ntiles_t, ph_lo, ph_hi;
};

DI unsigned pack2(float a, float b) { f32x2 v = {a, b}; return __builtin_bit_cast(unsigned, __builtin_convertvector(v, bf2_t)); }
DI bf16_t f2bf(float a) { return (bf16_t)(pack2(a, 0.f) & 0xffffu); }
DI float sigmoidf_(float x) { return 1.f / (1.f + __expf(-x)); }
DI float geluf_(float x) { return 0.5f * x * (1.f + erff(x * 0.70710678118f)); }
DI float bflo(unsigned w) { return __uint_as_float(w << 16); }
DI float bfhi(unsigned w) { return __uint_as_float(w & 0xffff0000u); }
DI u32x4 cvt8(f32x4 a, f32x4 b) { u32x4 r; r[0] = pack2(a[0], a[1]); r[1] = pack2(a[2], a[3]); r[2] = pack2(b[0], b[1]); r[3] = pack2(b[2], b[3]); return r; }
DI f32x16 zero16() { f32x16 z; for (int i = 0; i < 16; ++i) z[i] = 0.f; return z; }

template <int TM, int TN, class AL, class BL>
DI void gemm_kloop(f32x16 (&acc)[TM][TN], const int nk, AL aload, BL bload, unsigned char* smem) {
  constexpr int BM = 128 * TM, BN = 64 * TN;
  constexpr int STAGE = (BM + BN) * 144;
  const int tid = threadIdx.x, lane = tid & 63, w = tid >> 6, wr = w >> 1, wc = w & 1, l32 = lane & 31, h = lane >> 5;
  u32x4 ra[2 * TM], rb[TN];
#pragma unroll
  for (int i = 0; i < 2 * TM; ++i) { int c = tid + i * NTHR; ra[i] = aload(c >> 3, (c & 7) * 8, 0); }
#pragma unroll
  for (int i = 0; i < TN; ++i) { int c = tid + i * NTHR; rb[i] = bload(c >> 3, (c & 7) * 8, 0); }
  __syncthreads();
#pragma unroll
  for (int i = 0; i < 2 * TM; ++i) { int c = tid + i * NTHR; *(u32x4*)(smem + (c >> 3) * 144 + (c & 7) * 16) = ra[i]; }
#pragma unroll
  for (int i = 0; i < TN; ++i) { int c = tid + i * NTHR; *(u32x4*)(smem + BM * 144 + (c >> 3) * 144 + (c & 7) * 16) = rb[i]; }
  __syncthreads();
  for (int kt = 0; kt < nk; ++kt) {
    const int cur = kt & 1;
    const bool more = (kt + 1 < nk);
    if (more) {
#pragma unroll
      for (int i = 0; i < 2 * TM; ++i) { int c = tid + i * NTHR; ra[i] = aload(c >> 3, (c & 7) * 8, kt + 1); }
#pragma unroll
      for (int i = 0; i < TN; ++i) { int c = tid + i * NTHR; rb[i] = bload(c >> 3, (c & 7) * 8, kt + 1); }
    }
    const unsigned char* sA = smem + cur * STAGE;
    const unsigned char* sB = sA + BM * 144;
#pragma unroll
    for (int ks = 0; ks < 4; ++ks) {
      bf16x8 a[TM], b[TN];
#pragma unroll
      for (int tm = 0; tm < TM; ++tm) a[tm] = *(const bf16x8*)(sA + (wr * TM * 32 + tm * 32 + l32) * 144 + (ks * 2 + h) * 16);
#pragma unroll
      for (int tn = 0; tn < TN; ++tn) b[tn] = *(const bf16x8*)(sB + (wc * TN * 32 + tn * 32 + l32) * 144 + (ks * 2 + h) * 16);
#pragma unroll
      for (int tm = 0; tm < TM; ++tm)
#pragma unroll
        for (int tn = 0; tn < TN; ++tn) acc[tm][tn] = MFMA(a[tm], b[tn], acc[tm][tn]);
    }
    if (more) {
      unsigned char* dA = smem + (cur ^ 1) * STAGE;
#pragma unroll
      for (int i = 0; i < 2 * TM; ++i) { int c = tid + i * NTHR; *(u32x4*)(dA + (c >> 3) * 144 + (c & 7) * 16) = ra[i]; }
#pragma unroll
      for (int i = 0; i < TN; ++i) { int c = tid + i * NTHR; *(u32x4*)(dA + BM * 144 + (c >> 3) * 144 + (c & 7) * 16) = rb[i]; }
    }
    __syncthreads();
  }
}
template <int TM, int TN, class F>
DI void gemm_epi(f32x16 (&acc)[TM][TN], F f) {
  const int tid = threadIdx.x, lane = tid & 63, w = tid >> 6, wr = w >> 1, wc = w & 1, l32 = lane & 31, h = lane >> 5;
#pragma unroll
  for (int tm = 0; tm < TM; ++tm)
#pragma unroll
    for (int tn = 0; tn < TN; ++tn)
#pragma unroll
      for (int g = 0; g < 4; ++g)
        f(wr * TM * 32 + tm * 32 + 8 * g + 4 * h, wc * TN * 32 + tn * 32 + l32, acc[tm][tn][4 * g], acc[tm][tn][4 * g + 1], acc[tm][tn][4 * g + 2], acc[tm][tn][4 * g + 3]);
}
template <int TM, int TN>
DI void zero_acc(f32x16 (&acc)[TM][TN]) {
#pragma unroll
  for (int a = 0; a < TM; ++a)
#pragma unroll
    for (int b = 0; b < TN; ++b) acc[a][b] = zero16();
}
DI u32x4 ldg16(const bf16_t* p) { return *(const u32x4*)p; }

DI void phase_prep(const Params& P, unsigned char* smem) {
  const int tid = threadIdx.x;
  float* tl = (float*)smem;
  for (int tile = blockIdx.x; tile < P.ntiles_t; tile += gridDim.x) {
    int j = 0;
    while (j + 1 < P.njobs && P.jobs[j + 1].tile0 <= tile) ++j;
    const float* src = P.jobs[j].src; bf16_t* dst = P.jobs[j].dst;
    const int ld = P.jobs[j].ld, col0 = P.jobs[j].col0, ncols = P.jobs[j].ncols, K = P.jobs[j].K;
    const int lt = tile - P.jobs[j].tile0, nkt = K >> 6, nt = lt / nkt, k0 = (lt - nt * nkt) << 6;
    __syncthreads();
#pragma unroll
    for (int i = 0; i < 8; ++i) {
      int idx = tid + i * NTHR, kk = idx >> 6, nn = idx & 63, n = nt * 64 + nn;
      tl[kk * 65 + nn] = (n < ncols) ? src[(size_t)(k0 + kk) * ld + col0 + n] : 0.f;
    }
    __syncthreads();
#pragma unroll
    for (int i = 0; i < 4; ++i) {
      int idx = tid + i * NTHR, nn = idx >> 5, kp = idx & 31;
      *(unsigned*)(dst + (size_t)(nt * 64 + nn) * K + k0 + kp * 2) = pack2(tl[(kp * 2) * 65 + nn], tl[(kp * 2 + 1) * 65 + nn]);
    }
  }
  {
    const float* x = P.in[0]; bf16_t* xb = (bf16_t*)(P.ws + WS_XB);
    for (size_t i = (size_t)blockIdx.x * NTHR + tid; i < (size_t)T * DM / 8; i += (size_t)gridDim.x * NTHR) {
      f32x4 a = *(const f32x4*)(x + i * 8), b = *(const f32x4*)(x + i * 8 + 4);
      *(u32x4*)(xb + i * 8) = cvt8(a, b);
    }
    for (int i = blockIdx.x * NTHR + tid; i < 2 * 16384 / 8; i += gridDim.x * NTHR) {
      const int which = i >> 11, e = (i & 2047) * 8;
      const float* s = P.in[20 + which] + e;
      *(u32x4*)((bf16_t*)(P.ws + (which ? SM_SK2 : SM_SK1)) + e) = cvt8(*(const f32x4*)s, *(const f32x4*)(s + 4));
    }
  }
  if (blockIdx.x < 16) {
    const int which = tid >> 8, n = tid & 255, kb = blockIdx.x * 128;
    const float* pos = P.in[3 + which]; const float* w1 = P.in[which ? 7 : 5];
    float s = 0.f;
    for (int k = kb; k < kb + 128; ++k) s += pos[k] * w1[(size_t)k * 256 + n];
    ((float*)(P.ws + SM_CBIAS))[blockIdx.x * 512 + tid] = s;
  }
  if (blockIdx.x == 16 && tid == 0) {
    float a = 0.f, b = 0.f;
    for (int i = 0; i < 64; ++i) { a += P.in[9][i] * P.in[10][i]; b += P.in[11][i] * P.in[12][i]; }
    *(float*)(P.ws + SM_LAM) = expf(a) - expf(b) + 0.2f;
  }
}

DI void phase_inproj(const Params& P, unsigned char* smem) {
  const bf16_t* xb = (const bf16_t*)(P.ws + WS_XB);
  const bf16_t* wt = (const bf16_t*)(P.ws + WS_WINR);
  bf16_t* proj = (bf16_t*)(P.ws + R_PROJ);
  bf16_t* vT = (bf16_t*)(P.ws + R_VT);
  for (int tile = blockIdx.x; tile < 64 * 23; tile += gridDim.x) {
    const int mt = tile / 23, nt = tile - mt * 23;
    const int m0 = mt * 256, n0 = nt * 128;
    f32x16 acc[2][2]; zero_acc(acc);
    gemm_kloop<2, 2>(acc, 16,
      [&](int r, int ko, int kt) { return ldg16(xb + (size_t)(m0 + r) * DM + kt * 64 + ko); },
      [&](int r, int ko, int kt) { return ldg16(wt + (size_t)(n0 + r) * DM + kt * 64 + ko); }, smem);
    if (nt < 17) {
      const float sc = (nt < 4 || (nt >= 8 && nt < 12)) ? 0.125f : 1.f;
      const bool sg = (nt == 16);
      gemm_epi<2, 2>(acc, [&](int m, int n, float v0, float v1, float v2, float v3) {
        bf16_t* d = proj + (size_t)(m0 + m) * PJ + n0 + n;
        if (sg) { v0 = sigmoidf_(v0); v1 = sigmoidf_(v1); v2 = sigmoidf_(v2); v3 = sigmoidf_(v3); }
        else { v0 *= sc; v1 *= sc; v2 *= sc; v3 *= sc; }
        d[0] = f2bf(v0); d[PJ] = f2bf(v1); d[2 * PJ] = f2bf(v2); d[3 * PJ] = f2bf(v3);
      });
    } else {
      gemm_epi<2, 2>(acc, [&](int m, int n, float v0, float v1, float v2, float v3) {
        const int mm = m0 + m, b = mm >> 11, s = mm & 2047, c = n0 + n - 2176;
        u32x2 v = {pack2(v0, v1), pack2(v2, v3)};
        *(u32x2*)(vT + ((size_t)(b * 768 + c) * SEQ + s)) = v;
      });
    }
  }
}

DI void phase_cmp1(const Params& P, unsigned char* smem) {
  const bf16_t* proj = (const bf16_t*)(P.ws + R_PROJ);
  bf16_t* hid = (bf16_t*)(P.ws + R_HID);
  const float* cb = (const float*)(P.ws + SM_CBIAS);
  for (int tile = blockIdx.x; tile < 32; tile += gridDim.x) {
    const int which = tile >> 4, mt = (tile >> 1) & 7, nt = tile & 1;
    const bf16_t* w1 = (const bf16_t*)(P.ws + (which ? WS_CW1V : WS_CW1K));
    const int colbase = which ? 896 : 512;
    f32x16 acc[2][2]; zero_acc(acc);
    gemm_kloop<2, 2>(acc, 32,
      [&](int r, int ko, int kt) {
        const int m = mt * 256 + r, bg = m >> 7, c = min(m & 127, 126), b = bg >> 1, g = bg & 1;
        return ldg16(proj + (size_t)(b * SEQ + c * 16 + kt) * PJ + colbase + g * 64 + ko); },
      [&](int r, int ko, int kt) { return ldg16(w1 + (size_t)(nt * 128 + r) * 2048 + kt * 64 + ko); }, smem);
    gemm_epi<2, 2>(acc, [&](int m, int n, float v0, float v1, float v2, float v3) {
      const int nn = nt * 128 + n;
      float bias = 0.f;
#pragma unroll
      for (int j = 0; j < 16; ++j) bias += cb[j * 512 + which * 256 + nn];
      bf16_t* d = hid + ((size_t)which * 2048 + mt * 256 + m) * 256 + nn;
      d[0] = f2bf(geluf_(v0 + bias)); d[256] = f2bf(geluf_(v1 + bias)); d[512] = f2bf(geluf_(v2 + bias)); d[768] = f2bf(geluf_(v3 + bias));
    });
  }
}
DI void phase_cmp2(const Params& P, unsigned char* smem) {
  const bf16_t* hid = (const bf16_t*)(P.ws + R_HID);
  bf16_t* kc = (bf16_t*)(P.ws + R_KC);
  bf16_t* vcT = (bf16_t*)(P.ws + R_VCT);
  for (int tile = blockIdx.x; tile < 16; tile += gridDim.x) {
    const int which = tile >> 3, mt = tile & 7;
    const bf16_t* w2 = (const bf16_t*)(P.ws + (which ? SM_CW2V : SM_CW2K));
    f32x16 acc[2][1]; zero_acc(acc);
    gemm_kloop<2, 1>(acc, 4,
      [&](int r, int ko, int kt) { return ldg16(hid + ((size_t)which * 2048 + mt * 256 + r) * 256 + kt * 64 + ko); },
      [&](int r, int ko, int kt) { return ldg16(w2 + (size_t)r * 256 + kt * 64 + ko); }, smem);
    gemm_epi<2, 1>(acc, [&](int m, int n, float v0, float v1, float v2, float v3) {
      const int mm = mt * 256 + m, bg = mm >> 7, c = mm & 127;
      if (which == 0) {
        bf16_t* d = kc + ((size_t)bg * 128 + c) * 64 + n;
        d[0] = f2bf(v0); d[64] = f2bf(v1); d[128] = f2bf(v2); d[192] = f2bf(v3);
      } else {
        u32x2 v = {pack2(v0, v1), pack2(v2, v3)};
        *(u32x2*)(vcT + ((size_t)bg * 64 + n) * 128 + c) = v;
      }
    });
  }
}

DI int crow(int i, int h) { return (i & 3) + 8 * (i >> 2) + 4 * h; }
DI bf16x8 pack8(const f32x16& x, int s) {
  u32x4 p;
  p[0] = pack2(x[8 * s + 0], x[8 * s + 1]); p[1] = pack2(x[8 * s + 2], x[8 * s + 3]);
  p[2] = pack2(x[8 * s + 4], x[8 * s + 5]); p[3] = pack2(x[8 * s + 6], x[8 * s + 7]);
  return __builtin_bit_cast(bf16x8, p);
}
DI void qk64(f32x16* s, const unsigned char* sK, int rstride, const bf16x8 (&q)[4], int l32, int h) {
#pragma unroll
  for (int kt = 0; kt < 2; ++kt) {
    s[kt] = zero16();
#pragma unroll
    for (int ks = 0; ks < 4; ++ks) {
      bf16x8 a = *(const bf16x8*)(sK + (kt * 32 + l32) * rstride + (ks * 2 + h) * 16);
      s[kt] = MFMA(a, q[ks], s[kt]);
    }
  }
}
template <int NDV>
DI void pv64(f32x16 (&o)[NDV], const f32x16* p, const unsigned char* sV, int rstride, int kofs, int l32, int h) {
#pragma unroll
  for (int ks = 0; ks < 4; ++ks) {
    bf16x8 pb = pack8(p[ks >> 1], ks & 1);
#pragma unroll
    for (int dvt = 0; dvt < NDV; ++dvt) {
      const unsigned char* r = sV + (dvt * 32 + l32) * rstride + (kofs + ks * 16 + 4 * h) * 2;
      s16x4 lo = *(const s16x4*)r, hi = *(const s16x4*)(r + 16);
      bf16x8 a = __builtin_shufflevector(lo, hi, 0, 1, 2, 3, 4, 5, 6, 7);
      o[dvt] = MFMA(a, pb, o[dvt]);
    }
  }
}
template <int NDV>
DI void softmax64(f32x16 (&s)[2], float& m, float& l, f32x16 (&o)[NDV], int t, int kbase, float slope, bool sel, int hi, int h) {
  float mx = m;
#pragma unroll
  for (int kt = 0; kt < 2; ++kt)
#pragma unroll
    for (int i = 0; i < 16; ++i) {
      const int dist = t - (kbase + kt * 32 + crow(i, h));
      const bool valid = sel && dist >= 0 && dist < hi;
      const float sv = valid ? s[kt][i] - slope * (float)dist : NEGBIG;
      s[kt][i] = sv; mx = fmaxf(mx, sv);
    }
  mx = fmaxf(mx, __shfl_xor(mx, 32));
  const float alpha = __expf(m - mx);
  float ls = 0.f;
#pragma unroll
  for (int kt = 0; kt < 2; ++kt)
#pragma unroll
    for (int i = 0; i < 16; ++i) {
      const float pv = (s[kt][i] > -1.0e29f) ? __expf(s[kt][i] - mx) : 0.f;
      s[kt][i] = pv; ls += pv;
    }
  l = l * alpha + ls; m = mx;
#pragma unroll
  for (int d = 0; d < NDV; ++d) o[d] *= alpha;
}

DI void nsa_item(const Params& P, int item, unsigned char* smem) {
  const int tid = threadIdx.x, lane = tid & 63, w = tid >> 6, l32 = lane & 31, h = lane >> 5;
  const int qb = item & 31, bg = item >> 5, b = bg >> 1, g = bg & 1;
  const int hw = w & 3, qt = w >> 2, head = g * 4 + hw;
  const int q64 = qt * 32 + l32, t = qb * 64 + q64;
  const size_t token = (size_t)b * SEQ + t;
  const float slope = exp2f(-(float)(head + 1));
  const bf16_t* proj = (const bf16_t*)(P.ws + R_PROJ);
  const bf16_t* vT = (const bf16_t*)(P.ws + R_VT);
  unsigned char* sK = smem;
  unsigned char* sV = smem + 18432;
  float* imp = (float*)(smem + 36864);
  unsigned* umask = (unsigned*)(smem + 36864 + 8448);

  bf16x8 q[4];
#pragma unroll
  for (int ks = 0; ks < 4; ++ks) q[ks] = *(const bf16x8*)(proj + token * PJ + head * 64 + ks * 16 + h * 8);
  const float g0 = __uint_as_float((unsigned)proj[token * PJ + 2048 + head * 3 + 0] << 16);
  const float g1 = __uint_as_float((unsigned)proj[token * PJ + 2048 + head * 3 + 1] << 16);
  const float g2 = __uint_as_float((unsigned)proj[token * PJ + 2048 + head * 3 + 2] << 16);

  __syncthreads();
  for (int i = tid; i < 64 * 33; i += NTHR) imp[i] = 0.f;
  if (tid == 0) *umask = 0u;
  {
    const bf16_t* kc = (const bf16_t*)(P.ws + R_KC) + (size_t)bg * 128 * 64;
    const bf16_t* vc = (const bf16_t*)(P.ws + R_VCT) + (size_t)bg * 64 * 128;
#pragma unroll
    for (int i = 0; i < 2; ++i) {
      int c = tid + i * NTHR;
      *(u32x4*)(sK + (c >> 3) * 144 + (c & 7) * 16) = ldg16(kc + (c >> 3) * 64 + (c & 7) * 8);
      *(u32x4*)(sV + (c >> 4) * 272 + (c & 15) * 16) = ldg16(vc + (c >> 4) * 128 + (c & 15) * 8);
    }
  }
  __syncthreads();
  f32x16 comb[2];
  {
    f32x16 sc[4];
    qk64(sc, sK, 144, q, l32, h);
    qk64(sc + 2, sK + 64 * 144, 144, q, l32, h);
    float mx = NEGBIG;
#pragma unroll
    for (int kt = 0; kt < 4; ++kt)
#pragma unroll
      for (int i = 0; i < 16; ++i) {
        const int c = kt * 32 + crow(i, h);
        const int dist = t - (c * 16 + 31);
        const float r = (dist >= 0) ? sc[kt][i] - slope * (float)dist : NEGBIG;
        sc[kt][i] = r;
        mx = fmaxf(mx, r);
      }
    mx = fmaxf(mx, __shfl_xor(mx, 32));
    float ls = 0.f;
#pragma unroll
    for (int kt = 0; kt < 4; ++kt)
#pragma unroll
      for (int i = 0; i < 16; ++i) {
        const float r = (sc[kt][i] > -1.0e29f) ? __expf(sc[kt][i] - mx) : 0.f;
        sc[kt][i] = r;
        ls += r;
      }
    ls += __shfl_xor(ls, 32);
    const float inv = 1.f / fmaxf(ls, 1.0e-30f);
#pragma unroll
    for (int kt = 0; kt < 4; ++kt)
#pragma unroll
      for (int gq = 0; gq < 4; ++gq) {
        const float p0 = sc[kt][4 * gq] * inv, p1 = sc[kt][4 * gq + 1] * inv, p2 = sc[kt][4 * gq + 2] * inv, p3 = sc[kt][4 * gq + 3] * inv;
        sc[kt][4 * gq] = p0; sc[kt][4 * gq + 1] = p1; sc[kt][4 * gq + 2] = p2; sc[kt][4 * gq + 3] = p3;
        const int j = 8 * kt + 2 * gq + h;
        const float sp = 0.5f * p3;
        atomicAdd(&imp[q64 * 33 + j], p0 + p1 + p2 + sp);
        atomicAdd(&imp[q64 * 33 + j + 1], sp);
      }
    f32x16 o[2]; o[0] = zero16(); o[1] = zero16();
    pv64<2>(o, sc, sV, 272, 0, l32, h);
    pv64<2>(o, sc + 2, sV, 272, 64, l32, h);
    comb[0] = o[0] * g0; comb[1] = o[1] * g0;
  }
  __syncthreads();
  const int cur = qb;
  unsigned mask = 1u | (1u << cur) | (cur >= 1 ? (1u << (cur - 1)) : 0u);
  {
    float tv[5]; int ti[5];
#pragma unroll
    for (int k = 0; k < 5; ++k) { tv[k] = -1.f; ti[k] = -1; }
    for (int j = 1; j <= cur - 2; ++j) {
      float v = imp[q64 * 33 + j]; int vi = j;
#pragma unroll
      for (int k = 0; k < 5; ++k) {
        const bool gt = v > tv[k];
        const float nv = gt ? tv[k] : v; const int ni = gt ? ti[k] : vi;
        tv[k] = gt ? v : tv[k]; ti[k] = gt ? vi : ti[k];
        v = nv; vi = ni;
      }
    }
#pragma unroll
    for (int k = 0; k < 5; ++k) if (ti[k] >= 0) mask |= (1u << ti[k]);
  }
  {
    unsigned um = mask;
#pragma unroll
    for (int off = 32; off >= 1; off >>= 1) um |= (unsigned)__shfl_xor((int)um, off);
    if (lane == 0) atomicOr(umask, um);
  }
  __syncthreads();
  const unsigned un = *umask;
#pragma unroll 1
  for (int br = 0; br < 2; ++br) {
    const int kcol = (br == 0 ? 640 : 768) + g * 64;
    const int vrow = (br == 0 ? 0 : 128) + g * 64;
    const int j0 = (br == 0) ? 0 : max(0, cur - 8);
    const int hi = (br == 0) ? 0x7fffffff : 512;
    float m = NEGBIG, l = 0.f;
    f32x16 o[2]; o[0] = zero16(); o[1] = zero16();
#pragma unroll 1
    for (int j = j0; j <= cur; ++j) {
      if (br == 0 && !((un >> j) & 1u)) continue;
      __syncthreads();
      {
        const int r = tid >> 3, part = tid & 7;
        *(u32x4*)(sK + r * 144 + part * 16) = ldg16(proj + ((size_t)b * SEQ + j * 64 + r) * PJ + kcol + part * 8);
        *(u32x4*)(sV + r * 144 + part * 16) = ldg16(vT + ((size_t)(b * 768 + vrow + r) * SEQ + j * 64 + part * 8));
      }
      __syncthreads();
      f32x16 s[2];
      qk64(s, sK, 144, q, l32, h);
      const bool sel = (br == 0) ? (((mask >> j) & 1u) != 0u) : true;
      softmax64<2>(s, m, l, o, t, j * 64, slope, sel, hi, h);
      pv64<2>(o, s, sV, 144, 0, l32, h);
    }
    l += __shfl_xor(l, 32);
    const float sc = (br == 0 ? g1 : g2) / fmaxf(l, 1.0e-30f);
    comb[0] += o[0] * sc; comb[1] += o[1] * sc;
  }
  bf16_t* on = (bf16_t*)(P.ws + R_ONSA) + token * 512 + head * 64;
#pragma unroll
  for (int dvt = 0; dvt < 2; ++dvt)
#pragma unroll
    for (int gq = 0; gq < 4; ++gq) {
      u32x2 v = {pack2(comb[dvt][4 * gq], comb[dvt][4 * gq + 1]), pack2(comb[dvt][4 * gq + 2], comb[dvt][4 * gq + 3])};
      *(u32x2*)(on + dvt * 32 + 8 * gq + 4 * h) = v;
    }
}

DI void diff_item(const Params& P, int item, unsigned char* smem) {
  const int tid = threadIdx.x, lane = tid & 63, w = tid >> 6, l32 = lane & 31, h = lane >> 5;
  const int qb = item & 15, bh = item >> 4, b = bh >> 2, head = bh & 3;
  const int map = w >> 2, qt = w & 3;
  const int t = qb * 128 + qt * 32 + l32;
  const size_t token = (size_t)b * SEQ + t;
  const float slope = exp2f(-2.f * (float)(head + 1));
  const bf16_t* proj = (const bf16_t*)(P.ws + R_PROJ);
  const bf16_t* vT = (const bf16_t*)(P.ws + R_VT);
  unsigned char* sK1 = smem; unsigned char* sK2 = smem + 9216; unsigned char* sV = smem + 18432;
  bf16x8 q[4];
#pragma unroll
  for (int ks = 0; ks < 4; ++ks) q[ks] = *(const bf16x8*)(proj + token * PJ + 1024 + map * 256 + head * 64 + ks * 16 + h * 8);
  float m = NEGBIG, l = 0.f;
  f32x16 o[4];
#pragma unroll
  for (int d = 0; d < 4; ++d) o[d] = zero16();
  const int tmax_w = qb * 128 + qt * 32 + 31;
#pragma unroll 1
  for (int j = 0; j <= 2 * qb + 1; ++j) {
    __syncthreads();
    {
      const int r = tid >> 3, part = tid & 7;
      const bf16_t* kr = proj + ((size_t)b * SEQ + j * 64 + r) * PJ + 1536 + head * 64 + part * 8;
      *(u32x4*)(sK1 + r * 144 + part * 16) = ldg16(kr);
      *(u32x4*)(sK2 + r * 144 + part * 16) = ldg16(kr + 256);
#pragma unroll
      for (int i = 0; i < 2; ++i) {
        const int c = tid + i * NTHR, dv = c >> 3, pp = c & 7;
        *(u32x4*)(sV + dv * 144 + pp * 16) = ldg16(vT + ((size_t)(b * 768 + 256 + head * 128 + dv) * SEQ + j * 64 + pp * 8));
      }
    }
    __syncthreads();
    if (j * 64 <= tmax_w) {
      f32x16 s[2];
      qk64(s, map ? sK2 : sK1, 144, q, l32, h);
      softmax64<4>(s, m, l, o, t, j * 64, slope, true, 0x7fffffff, h);
      pv64<4>(o, s, sV, 144, 0, l32, h);
    }
  }
  l += __shfl_xor(l, 32);
  const float inv = 1.f / fmaxf(l, 1.0e-30f);
  __syncthreads();
  float* ex = (float*)smem;
  if (map == 1) {
#pragma unroll
    for (int d = 0; d < 4; ++d)
#pragma unroll
      for (int i = 0; i < 16; ++i) ex[(qt * 64 + d * 16 + i) * 64 + lane] = o[d][i] * inv;
  }
  __syncthreads();
  if (map == 0) {
    const float lam = *(const float*)(P.ws + SM_LAM);
    float ss = 0.f;
#pragma unroll
    for (int d = 0; d < 4; ++d)
#pragma unroll
      for (int i = 0; i < 16; ++i) {
        const float v = o[d][i] * inv - lam * ex[(qt * 64 + d * 16 + i) * 64 + lane];
        o[d][i] = v; ss += v * v;
      }
    ss += __shfl_xor(ss, 32);
    const float r = rsqrtf(ss * (1.f / 128.f) + 1.0e-5f) * 0.8f;
    const float* ng = P.in[13];
    bf16_t* od = (bf16_t*)(P.ws + R_ODIFF) + token * 512 + head * 128;
#pragma unroll
    for (int d = 0; d < 4; ++d)
#pragma unroll
      for (int gq = 0; gq < 4; ++gq) {
        const int dv = d * 32 + 8 * gq + 4 * h;
        const f32x4 gg = *(const f32x4*)(ng + dv);
        u32x2 v = {pack2(o[d][4 * gq] * r * gg[0], o[d][4 * gq + 1] * r * gg[1]), pack2(o[d][4 * gq + 2] * r * gg[2], o[d][4 * gq + 3] * r * gg[3])};
        *(u32x2*)(od + dv) = v;
      }
  }
}

DI void phase_attn(const Params& P, unsigned char* smem) {
  for (int it = blockIdx.x; it < 1024; it += gridDim.x) {
    if (it < 512) {
      const int bh = it & 31, qb = 15 - (it >> 5);
      diff_item(P, bh * 16 + qb, smem);
    } else {
      const int i2 = it - 512, bg = i2 & 15, qb = 31 - (i2 >> 4);
      nsa_item(P, bg * 32 + qb, smem);
    }
  }
}

DI void phase_merge(const Params& P, unsigned char* smem) {
  const bf16_t* xb = (const bf16_t*)(P.ws + WS_XB);
  const bf16_t* wg = (const bf16_t*)(P.ws + WS_WGATE);
  const bf16_t* wbn = (const bf16_t*)(P.ws + WS_WBN);
  const bf16_t* wbd = (const bf16_t*)(P.ws + WS_WBD);
  const bf16_t* onsa = (const bf16_t*)(P.ws + R_ONSA);
  const bf16_t* odiff = (const bf16_t*)(P.ws + R_ODIFF);
  bf16_t* merged = (bf16_t*)(P.ws + R_MERGED);
  for (int tile = blockIdx.x; tile < 64 * 16; tile += gridDim.x) {
    const int mt = tile >> 4, nt = tile & 15, m0 = mt * 256, n0 = nt * 64;
    f32x16 res[2][1]; zero_acc(res);
#pragma unroll 1
    for (int br = 0; br < 2; ++br) {
      f32x16 ga[2][1], va[2][1]; zero_acc(ga); zero_acc(va);
      const bf16_t* wgb = wg + (size_t)br * 1024 * DM;
      gemm_kloop<2, 1>(ga, 16,
        [&](int r, int ko, int kt) { return ldg16(xb + (size_t)(m0 + r) * DM + kt * 64 + ko); },
        [&](int r, int ko, int kt) { return ldg16(wgb + (size_t)(n0 + r) * DM + kt * 64 + ko); }, smem);
      const bf16_t* oa = br ? odiff : onsa; const bf16_t* wb = br ? wbd : wbn;
      gemm_kloop<2, 1>(va, 8,
        [&](int r, int ko, int kt) { return ldg16(oa + (size_t)(m0 + r) * 512 + kt * 64 + ko); },
        [&](int r, int ko, int kt) { return ldg16(wb + (size_t)(n0 + r) * 512 + kt * 64 + ko); }, smem);
#pragma unroll
      for (int tm = 0; tm < 2; ++tm)
#pragma unroll
        for (int i = 0; i < 16; ++i) res[tm][0][i] += sigmoidf_(ga[tm][0][i]) * va[tm][0][i];
    }
    gemm_epi<2, 1>(res, [&](int m, int n, float v0, float v1, float v2, float v3) {
      bf16_t* d = merged + (size_t)(m0 + m) * DM + n0 + n;
      d[0] = f2bf(v0); d[DM] = f2bf(v1); d[2 * DM] = f2bf(v2); d[3 * DM] = f2bf(v3);
    });
  }
}
DI void phase_outproj(const Params& P, unsigned char* smem) {
  const bf16_t* merged = (const bf16_t*)(P.ws + R_MERGED);
  const bf16_t* wo = (const bf16_t*)(P.ws + WS_WOUT);
  const float* x = P.in[0];
  for (int tile = blockIdx.x; tile < 64 * 8; tile += gridDim.x) {
    const int mt = tile >> 3, nt = tile & 7, m0 = mt * 256, n0 = nt * 128;
    f32x16 acc[2][2]; zero_acc(acc);
    gemm_kloop<2, 2>(acc, 16,
      [&](int r, int ko, int kt) { return ldg16(merged + (size_t)(m0 + r) * DM + kt * 64 + ko); },
      [&](int r, int ko, int kt) { return ldg16(wo + (size_t)(n0 + r) * DM + kt * 64 + ko); }, smem);
    gemm_epi<2, 2>(acc, [&](int m, int n, float v0, float v1, float v2, float v3) {
      const size_t o = (size_t)(m0 + m) * DM + n0 + n;
      P.out[o] = LN_ALPHA * x[o] + v0; P.out[o + DM] = LN_ALPHA * x[o + DM] + v1;
      P.out[o + 2 * DM] = LN_ALPHA * x[o + 2 * DM] + v2; P.out[o + 3 * DM] = LN_ALPHA * x[o + 3 * DM] + v3;
    });
  }
}
DI float wave_sum(float v) {
#pragma unroll
  for (int off = 32; off >= 1; off >>= 1) v += __shfl_xor(v, off);
  return v;
}
DI void phase_ln1(const Params& P) {
  const int tid = threadIdx.x, lane = tid & 63, w = tid >> 6;
  const float* gam = P.in[17]; const float* bet = P.in[18];
  bf16_t* hb = (bf16_t*)(P.ws + WS_XB);
  for (int row = blockIdx.x * 8 + w; row < T; row += gridDim.x * 8) {
    float* r = P.out + (size_t)row * DM;
    f32x4 v[4];
    v[0] = *(f32x4*)(r + lane * 8); v[1] = *(f32x4*)(r + lane * 8 + 4); v[2] = *(f32x4*)(r + 512 + lane * 8); v[3] = *(f32x4*)(r + 512 + lane * 8 + 4);
    float s = 0.f;
#pragma unroll
    for (int i = 0; i < 4; ++i) s += v[i][0] + v[i][1] + v[i][2] + v[i][3];
    const float mu = wave_sum(s) * (1.f / 1024.f);
    float ss = 0.f;
#pragma unroll
    for (int i = 0; i < 4; ++i)
#pragma unroll
      for (int k = 0; k < 4; ++k) { const float d = v[i][k] - mu; ss += d * d; }
    const float rs = rsqrtf(wave_sum(ss) * (1.f / 1024.f) + 1.0e-5f);
#pragma unroll
    for (int i = 0; i < 4; ++i) {
      const int c = (i >> 1) * 512 + lane * 8 + (i & 1) * 4;
      const f32x4 gg = *(const f32x4*)(gam + c), bb = *(const f32x4*)(bet + c);
#pragma unroll
      for (int k = 0; k < 4; ++k) v[i][k] = (v[i][k] - mu) * rs * gg[k] + bb[k];
      *(f32x4*)(r + c) = v[i];
    }
    *(u32x4*)(hb + (size_t)row * DM + lane * 8) = cvt8(v[0], v[1]);
    *(u32x4*)(hb + (size_t)row * DM + 512 + lane * 8) = cvt8(v[2], v[3]);
  }
  for (size_t i = (size_t)blockIdx.x * NTHR + tid; i < (size_t)2 * 16384 * 1024 / 8; i += (size_t)gridDim.x * NTHR) {
    const int which = (int)(i >> 21); const size_t e = (i & ((1u << 21) - 1)) * 8;
    const float* s = P.in[22 + which] + e;
    *(u32x4*)((bf16_t*)(P.ws + (which ? R_VB : R_UB)) + e) = cvt8(*(const f32x4*)s, *(const f32x4*)(s + 4));
  }
}

DI void bubble16(float (&tv)[16], float v) {
#pragma unroll
  for (int k = 0; k < 16; ++k) { const float hi = fmaxf(tv[k], v); v = fminf(tv[k], v); tv[k] = hi; }
}
DI void phase_route(const Params& P, unsigned char* smem) {
  const int tid = threadIdx.x, lane = tid & 63, w = tid >> 6, l32 = lane & 31, h = lane >> 5;
  const bf16_t* hb = (const bf16_t*)(P.ws + WS_XB);
  const bf16_t* wq = (const bf16_t*)(P.ws + WS_WQ);
  int* eid = (int*)(P.ws + R_EID);
  float* gw = (float*)(P.ws + R_GW);
  unsigned char* idxb = smem + 110592 + tid * 32;
  for (int tile = blockIdx.x; tile < 64 * 8; tile += gridDim.x) {
    const int mt = tile >> 3, hd = tile & 7, m0 = mt * 256;
    float top[2][16];
#pragma unroll
    for (int half = 0; half < 2; ++half) {
      const int n0 = hd * 256 + half * 128;
      f32x16 acc[2][2]; zero_acc(acc);
      gemm_kloop<2, 2>(acc, 16,
        [&](int r, int ko, int kt) { return ldg16(hb + (size_t)(m0 + r) * DM + kt * 64 + ko); },
        [&](int r, int ko, int kt) { return ldg16(wq + (size_t)(n0 + r) * DM + kt * 64 + ko); }, smem);
      gemm_epi<2, 2>(acc, [&](int m, int n, float v0, float v1, float v2, float v3) {
        bf16_t* d = (bf16_t*)smem + m * 136 + n;
        d[0] = f2bf(v0); d[136] = f2bf(v1); d[272] = f2bf(v2); d[408] = f2bf(v3);
      });
      {
        const bf16_t* sk = (const bf16_t*)(P.ws + (half ? SM_SK2 : SM_SK1));
#pragma unroll
        for (int i = 0; i < 4; ++i) {
          const int c = tid + i * NTHR;
          *(u32x4*)(smem + 69632 + (c >> 4) * 272 + (c & 15) * 16) = ldg16(sk + (c >> 4) * 128 + (c & 15) * 8);
        }
      }
      __syncthreads();
      float tv[16];
#pragma unroll
      for (int k = 0; k < 16; ++k) tv[k] = -3.0e38f;
#pragma unroll 1
      for (int ktp = 0; ktp < 2; ++ktp) {
        f32x16 st[2]; st[0] = zero16(); st[1] = zero16();
#pragma unroll 2
        for (int ks = 0; ks < 8; ++ks) {
          const bf16x8 qf = *(const bf16x8*)(smem + (w * 32 + l32) * 272 + (ks * 2 + h) * 16);
#pragma unroll
          for (int kk = 0; kk < 2; ++kk) {
            const bf16x8 a = *(const bf16x8*)(smem + 69632 + ((ktp * 2 + kk) * 32 + l32) * 272 + (ks * 2 + h) * 16);
            st[kk] = MFMA(a, qf, st[kk]);
          }
        }
#pragma unroll
        for (int kk = 0; kk < 2; ++kk)
#pragma unroll
          for (int i = 0; i < 16; ++i) {
            const unsigned key = (unsigned)((ktp * 2 + kk) * 32 + crow(i, h));
            bubble16(tv, __uint_as_float((__float_as_uint(st[kk][i]) & ~127u) | key));
          }
      }
      float pv[16];
#pragma unroll
      for (int k = 0; k < 16; ++k) pv[k] = __shfl_xor(tv[k], 32);
#pragma unroll
      for (int k = 0; k < 16; ++k) bubble16(tv, pv[k]);
#pragma unroll
      for (int k = 0; k < 16; ++k) top[half][k] = tv[k];
    }
#pragma unroll
    for (int k = 0; k < 16; ++k) { idxb[k] = (unsigned char)(__float_as_uint(top[0][k]) & 127u); idxb[16 + k] = (unsigned char)(__float_as_uint(top[1][k]) & 127u); }
    float tv[16];
#pragma unroll
    for (int k = 0; k < 16; ++k) tv[k] = -3.0e38f;
#pragma unroll
    for (int a = 0; a < 16; ++a)
#pragma unroll
      for (int bb = 0; bb < 16; ++bb)
        if ((a + 1) * (bb + 1) <= 16) {
          const float sum = __uint_as_float(__float_as_uint(top[0][a]) & ~127u) + __uint_as_float(__float_as_uint(top[1][bb]) & ~127u);
          bubble16(tv, __uint_as_float((__float_as_uint(sum) & ~255u) | (unsigned)(a * 16 + bb)));
        }
    float e[16], es = 0.f;
    const float mx = __uint_as_float(__float_as_uint(tv[0]) & ~255u);
#pragma unroll
    for (int k = 0; k < 16; ++k) { e[k] = __expf(__uint_as_float(__float_as_uint(tv[k]) & ~255u) - mx); es += e[k]; }
    const float inv = 1.f / es;
    if (h == 0) {
      const size_t base = ((size_t)(m0 + w * 32 + l32) * 8 + hd) * 16;
#pragma unroll
      for (int k = 0; k < 16; ++k) {
        const unsigned code = __float_as_uint(tv[k]) & 255u;
        eid[base + k] = (int)idxb[code >> 4] * 128 + (int)idxb[16 + (code & 15)];
        gw[base + k] = e[k] * inv;
      }
    }
    __syncthreads();
  }
}

DI void phase_gather(const Params& P) {
  const int tid = threadIdx.x, lane = tid & 63, w = tid >> 6;
  const bf16_t* ub = (const bf16_t*)(P.ws + R_UB);
  const bf16_t* vb = (const bf16_t*)(P.ws + R_VB);
  const int* eid = (const int*)(P.ws + R_EID);
  const float* gw = (const float*)(P.ws + R_GW);
  const float* gam = P.in[24]; const float* bet = P.in[25];
  bf16_t* hb = (bf16_t*)(P.ws + WS_XB);
  for (int tok = blockIdx.x * 8 + w; tok < T; tok += gridDim.x * 8) {
    float* r = P.out + (size_t)tok * DM;
    float x[16], acc[16];
    {
      f32x4 a = *(f32x4*)(r + lane * 8), b = *(f32x4*)(r + lane * 8 + 4), c = *(f32x4*)(r + 512 + lane * 8), d = *(f32x4*)(r + 512 + lane * 8 + 4);
#pragma unroll
      for (int k = 0; k < 4; ++k) { x[k] = a[k]; x[4 + k] = b[k]; x[8 + k] = c[k]; x[12 + k] = d[k]; }
    }
#pragma unroll
    for (int k = 0; k < 16; ++k) acc[k] = 0.f;
#pragma unroll 1
    for (int hd = 0; hd < 8; ++hd) {
      const int my_e = eid[(size_t)tok * 128 + hd * 16 + (lane & 15)];
      const float my_g = gw[(size_t)tok * 128 + hd * 16 + (lane & 15)];
      float dsel = 0.f;
#pragma unroll
      for (int bb = 0; bb < 2; ++bb) {
        float dp[8];
        u32x4 u0[8], u1[8];
#pragma unroll
        for (int e = 0; e < 8; ++e) {
          const int id = __builtin_amdgcn_readlane(my_e, bb * 8 + e);
          const bf16_t* ur = ub + (size_t)id * DM;
          u0[e] = *(const u32x4*)(ur + lane * 8); u1[e] = *(const u32x4*)(ur + 512 + lane * 8);
        }
#pragma unroll
        for (int e = 0; e < 8; ++e) {
          float s = 0.f;
#pragma unroll
          for (int k = 0; k < 4; ++k) {
            s += x[2 * k] * bflo(u0[e][k]) + x[2 * k + 1] * bfhi(u0[e][k]);
            s += x[8 + 2 * k] * bflo(u1[e][k]) + x[8 + 2 * k + 1] * bfhi(u1[e][k]);
          }
          dp[e] = s;
        }
#pragma unroll
        for (int off = 32; off >= 1; off >>= 1)
#pragma unroll
          for (int e = 0; e < 8; ++e) dp[e] += __shfl_xor(dp[e], off);
#pragma unroll
        for (int e = 0; e < 8; ++e) dsel = ((lane & 15) == bb * 8 + e) ? dp[e] : dsel;
      }
      const float wv = my_g * geluf_(dsel);
#pragma unroll
      for (int bb = 0; bb < 2; ++bb) {
        u32x4 v0[8], v1[8];
#pragma unroll
        for (int e = 0; e < 8; ++e) {
          const int id = __builtin_amdgcn_readlane(my_e, bb * 8 + e);
          const bf16_t* vr = vb + (size_t)id * DM;
          v0[e] = *(const u32x4*)(vr + lane * 8); v1[e] = *(const u32x4*)(vr + 512 + lane * 8);
        }
#pragma unroll
        for (int e = 0; e < 8; ++e) {
          const float wt = __builtin_bit_cast(float, __builtin_amdgcn_readlane(__builtin_bit_cast(int, wv), bb * 8 + e));
#pragma unroll
          for (int k = 0; k < 4; ++k) {
            acc[2 * k] += wt * bflo(v0[e][k]); acc[2 * k + 1] += wt * bfhi(v0[e][k]);
            acc[8 + 2 * k] += wt * bflo(v1[e][k]); acc[8 + 2 * k + 1] += wt * bfhi(v1[e][k]);
          }
        }
      }
    }
    float s = 0.f;
#pragma unroll
    for (int k = 0; k < 16; ++k) { acc[k] += LN_ALPHA * x[k]; s += acc[k]; }
    const float mu = wave_sum(s) * (1.f / 1024.f);
    float ss = 0.f;
#pragma unroll
    for (int k = 0; k < 16; ++k) { const float d = acc[k] - mu; ss += d * d; }
    const float rs = rsqrtf(wave_sum(ss) * (1.f / 1024.f) + 1.0e-5f);
    f32x4 o[4];
#pragma unroll
    for (int i = 0; i < 4; ++i) {
      const int c = (i >> 1) * 512 + lane * 8 + (i & 1) * 4;
      const f32x4 gg = *(const f32x4*)(gam + c), bb = *(const f32x4*)(bet + c);
#pragma unroll
      for (int k = 0; k < 4; ++k) o[i][k] = (acc[i * 4 + k] - mu) * rs * gg[k] + bb[k];
      *(f32x4*)(r + c) = o[i];
    }
    *(u32x4*)(hb + (size_t)tok * DM + lane * 8) = cvt8(o[0], o[1]);
    *(u32x4*)(hb + (size_t)tok * DM + 512 + lane * 8) = cvt8(o[2], o[3]);
  }
}

DI void phase_final(const Params& P, unsigned char* smem) {
  const bf16_t* hb = (const bf16_t*)(P.ws + WS_XB);
  const bf16_t* wpg = (const bf16_t*)(P.ws + WS_WPG);
  const bf16_t* wpp = (const bf16_t*)(P.ws + WS_WPP);
  const float* pp = P.in[1];
  for (int tile = blockIdx.x; tile < 64 * 8; tile += gridDim.x) {
    const int mt = tile >> 3, nt = tile & 7, m0 = mt * 256, n0 = nt * 128;
    f32x16 ag[2][2], ap[2][2]; zero_acc(ag); zero_acc(ap);
    gemm_kloop<2, 2>(ag, 16,
      [&](int r, int ko, int kt) { return ldg16(hb + (size_t)(m0 + r) * DM + kt * 64 + ko); },
      [&](int r, int ko, int kt) { return ldg16(wpg + (size_t)(n0 + r) * DM + kt * 64 + ko); }, smem);
    gemm_kloop<2, 2>(ap, 4,
      [&](int r, int ko, int kt) { const float* s = pp + (size_t)(m0 + r) * 256 + kt * 64 + ko; return cvt8(*(const f32x4*)s, *(const f32x4*)(s + 4)); },
      [&](int r, int ko, int kt) { return ldg16(wpp + (size_t)(n0 + r) * 256 + kt * 64 + ko); }, smem);
#pragma unroll
    for (int tm = 0; tm < 2; ++tm)
#pragma unroll
      for (int tn = 0; tn < 2; ++tn)
#pragma unroll
        for (int i = 0; i < 16; ++i) ag[tm][tn][i] = sigmoidf_(ag[tm][tn][i]) * ap[tm][tn][i];
    gemm_epi<2, 2>(ag, [&](int m, int n, float v0, float v1, float v2, float v3) {
      const size_t o = (size_t)(m0 + m) * DM + n0 + n;
      P.out[o] += v0; P.out[o + DM] += v1; P.out[o + 2 * DM] += v2; P.out[o + 3 * DM] += v3;
    });
  }
}

__global__ void __launch_bounds__(NTHR) mk_fwd(Params P) {
  extern __shared__ __attribute__((aligned(16))) unsigned char smem[];
  cg::grid_group grid = cg::this_grid();
  if ((PHASE_MASK & (1 << 0)) && P.ph_lo <= 0 && 0 < P.ph_hi) {
    if (P.ph_lo < 0) grid.sync();
    phase_prep(P, smem);
    asm volatile("" ::: "memory");
  }
  if ((PHASE_MASK & (1 << 1)) && P.ph_lo <= 1 && 1 < P.ph_hi) {
    if (P.ph_lo < 1) grid.sync();
    phase_inproj(P, smem);
    asm volatile("" ::: "memory");
  }
  if ((PHASE_MASK & (1 << 2)) && P.ph_lo <= 2 && 2 < P.ph_hi) {
    if (P.ph_lo < 2) grid.sync();
    phase_cmp1(P, smem);
    asm volatile("" ::: "memory");
  }
  if ((PHASE_MASK & (1 << 3)) && P.ph_lo <= 3 && 3 < P.ph_hi) {
    if (P.ph_lo < 3) grid.sync();
    phase_cmp2(P, smem);
    asm volatile("" ::: "memory");
  }
  if ((PHASE_MASK & (1 << 4)) && P.ph_lo <= 4 && 4 < P.ph_hi) {
    if (P.ph_lo < 4) grid.sync();
    phase_attn(P, smem);
    asm volatile("" ::: "memory");
  }
  if ((PHASE_MASK & (1 << 5)) && P.ph_lo <= 5 && 5 < P.ph_hi) {
    if (P.ph_lo < 5) grid.sync();
    phase_merge(P, smem);
    asm volatile("" ::: "memory");
  }
  if ((PHASE_MASK & (1 << 6)) && P.ph_lo <= 6 && 6 < P.ph_hi) {
    if (P.ph_lo < 6) grid.sync();
    phase_outproj(P, smem);
    asm volatile("" ::: "memory");
  }
  if ((PHASE_MASK & (1 << 7)) && P.ph_lo <= 7 && 7 < P.ph_hi) {
    if (P.ph_lo < 7) grid.sync();
    phase_ln1(P);
    asm volatile("" ::: "memory");
  }
  if ((PHASE_MASK & (1 << 8)) && P.ph_lo <= 8 && 8 < P.ph_hi) {
    if (P.ph_lo < 8) grid.sync();
    phase_route(P, smem);
    asm volatile("" ::: "memory");
  }
  if ((PHASE_MASK & (1 << 9)) && P.ph_lo <= 9 && 9 < P.ph_hi) {
    if (P.ph_lo < 9) grid.sync();
    phase_gather(P);
    asm volatile("" ::: "memory");
  }
  if ((PHASE_MASK & (1 << 10)) && P.ph_lo <= 10 && 10 < P.ph_hi) {
    if (P.ph_lo < 10) grid.sync();
    phase_final(P, smem);
    asm volatile("" ::: "memory");
  }
}

static void add_job(Params& p, const float* src, size_t dst_off, int ld, int col0, int ncols, int npad, int K) {
  TJob& j = p.jobs[p.njobs++];
  j.src = src; j.dst = (bf16_t*)(p.ws + dst_off); j.ld = ld; j.col0 = col0; j.ncols = ncols; j.npad = npad; j.K = K; j.tile0 = p.ntiles_t;
  p.ntiles_t += (npad / 64) * (K / 64);
}

extern "C" void kernel_launch(void* const* d_in, const int* in_sizes, int n_in, void* d_out, int out_size, void* d_ws, size_t ws_size, hipStream_t stream) {
  static int grid = 0;
  if (grid == 0) {
    int dev = 0, cus = 0, per_cu = 0;
    hipGetDevice(&dev);
    hipDeviceGetAttribute(&cus, hipDeviceAttributeMultiprocessorCount, dev);
    hipFuncSetAttribute((const void*)mk_fwd, hipFuncAttributeMaxDynamicSharedMemorySize, LDS_BYTES);
    hipOccupancyMaxActiveBlocksPerMultiprocessor(&per_cu, (const void*)mk_fwd, NTHR, LDS_BYTES);
    if (per_cu < 1) { fprintf(stderr, "occupancy query returned %d\n", per_cu); per_cu = 1; }
    grid = cus * per_cu;
    (void)hipGetLastError();
  }
  Params p;
  memset(&p, 0, sizeof(p));
  for (int i = 0; i < 28; ++i) p.in[i] = (const float*)d_in[i];
  p.out = (float*)d_out; p.ws = (unsigned char*)d_ws;
  const float* w_in = p.in[2];
  const size_t e2 = 2;
  add_job(p, w_in, WS_WINR + e2 * 0 * 1024, 4888, 0, 512, 512, 1024);
  add_job(p, w_in, WS_WINR + e2 * 512 * 1024, 4888, 512, 128, 128, 1024);
  add_job(p, w_in, WS_WINR + e2 * 640 * 1024, 4888, 768, 128, 128, 1024);
  add_job(p, w_in, WS_WINR + e2 * 768 * 1024, 4888, 1024, 128, 128, 1024);
  add_job(p, w_in, WS_WINR + e2 * 896 * 1024, 4888, 640, 128, 128, 1024);
  add_job(p, w_in, WS_WINR + e2 * 1024 * 1024, 4888, 1304, 512, 512, 1024);
  add_job(p, w_in, WS_WINR + e2 * 1536 * 1024, 4888, 1816, 512, 512, 1024);
  add_job(p, w_in, WS_WINR + e2 * 2048 * 1024, 4888, 1280, 24, 128, 1024);
  add_job(p, w_in, WS_WINR + e2 * 2176 * 1024, 4888, 896, 128, 128, 1024);
  add_job(p, w_in, WS_WINR + e2 * 2304 * 1024, 4888, 1152, 128, 128, 1024);
  add_job(p, w_in, WS_WINR + e2 * 2432 * 1024, 4888, 2328, 512, 512, 1024);
  add_job(p, w_in, WS_WGATE, 4888, 2840, 2048, 2048, 1024);
  add_job(p, p.in[14], WS_WBN, 1024, 0, 1024, 1024, 512);
  add_job(p, p.in[15], WS_WBD, 1024, 0, 1024, 1024, 512);
  add_job(p, p.in[16], WS_WOUT, 1024, 0, 1024, 1024, 1024);
  add_job(p, p.in[19], WS_WQ, 2048, 0, 2048, 2048, 1024);
  add_job(p, p.in[27], WS_WPG, 1024, 0, 1024, 1024, 1024);
  add_job(p, p.in[26], WS_WPP, 1024, 0, 1024, 1024, 256);
  add_job(p, p.in[5], WS_CW1K, 256, 0, 256, 256, 2048);
  add_job(p, p.in[7], WS_CW1V, 256, 0, 256, 256, 2048);
  add_job(p, p.in[6], SM_CW2K, 64, 0, 64, 64, 256);
  add_job(p, p.in[8], SM_CW2V, 64, 0, 64, 64, 256);
#if MULTI_LAUNCH
  for (int ph = 0; ph < NPHASE; ++ph) {
    p.ph_lo = ph; p.ph_hi = ph + 1;
    hipLaunchKernelGGL(mk_fwd, dim3(grid), dim3(NTHR), LDS_BYTES, stream, p);
  }
#else
  p.ph_lo = 0; p.ph_hi = NPHASE;
  void* args[] = {&p};
  hipError_t e = hipLaunchCooperativeKernel((const void*)mk_fwd, dim3(grid), dim3(NTHR), args, LDS_BYTES, stream);
  if (e != hipSuccess) fprintf(stderr, "cooperative launch failed: %s (grid %d)\n", hipGetErrorString(e), grid);
#endif
}
```

```cpp
#include <hip/hip_runtime.h>
#include <hip/hip_cooperative_groups.h>
#include <cstdio>
#include <cstring>
namespace cg = cooperative_groups;

#ifndef PHASE_MASK
#define PHASE_MASK 0x7ff
#endif
#ifndef REPEAT_MASK
#define REPEAT_MASK 0
#endif
#ifndef PROBE_SEL
#define PROBE_SEL 3
#endif
#ifndef EXTRA_SYNCS
#define EXTRA_SYNCS 0
#endif
#ifndef MULTI_LAUNCH
#define MULTI_LAUNCH 0
#endif

#define DI __device__ __forceinline__
typedef short bf16x8 __attribute__((ext_vector_type(8)));
typedef short s16x4 __attribute__((ext_vector_type(4)));
typedef float f32x16 __attribute__((ext_vector_type(16)));
typedef float f32x4 __attribute__((ext_vector_type(4)));
typedef float f32x2 __attribute__((ext_vector_type(2)));
typedef unsigned u32x4 __attribute__((ext_vector_type(4)));
typedef unsigned u32x2 __attribute__((ext_vector_type(2)));
typedef __bf16 bf2_t __attribute__((ext_vector_type(2)));
typedef unsigned short bf16_t;

#define MFMA(a, b, c) __builtin_amdgcn_mfma_f32_32x32x16_bf16((a), (b), (c), 0, 0, 0)

constexpr int T = 16384, SEQ = 2048, DM = 1024;
constexpr int NTHR = 512;
constexpr int PJ = 2176;
constexpr int NPHASE = 11;
constexpr size_t MiB = 1u << 20;
constexpr size_t WS_WINR = 0, WS_WGATE = 6 * MiB, WS_WBN = 10 * MiB, WS_WBD = 11 * MiB, WS_WOUT = 12 * MiB, WS_WQ = 14 * MiB,
                 WS_WPG = 18 * MiB, WS_WPP = 20 * MiB, WS_CW1K = 21 * MiB, WS_CW1V = 22 * MiB, WS_SMALL = 23 * MiB,
                 WS_XB = 24 * MiB, WS_R = 56 * MiB;
constexpr size_t SM_CW2K = WS_SMALL, SM_CW2V = WS_SMALL + 32768, SM_SK1 = WS_SMALL + 65536, SM_SK2 = WS_SMALL + 98304,
                 SM_CBIAS = WS_SMALL + 131072  , SM_LAM = SM_CBIAS + 32768, SM_BAR = SM_LAM + 1024;
constexpr size_t R_PROJ = WS_R, R_VT = WS_R + 68 * MiB, R_HID = WS_R + 92 * MiB, R_KC = WS_R + 94 * MiB, R_VCT = R_KC + 262144,
                 R_ONSA = WS_R + 95 * MiB, R_ODIFF = WS_R + 111 * MiB;
constexpr size_t R_MERGED = WS_R, R_UB = WS_R + 32 * MiB, R_VB = WS_R + 64 * MiB, R_EID = WS_R + 96 * MiB, R_GW = WS_R + 104 * MiB;
constexpr size_t R_UB8 = 184 * MiB, R_VB8 = 200 * MiB, R_USC = 216 * MiB, R_VSC = R_USC + 65536;
constexpr size_t WS_H1 = 184 * MiB;
constexpr int LDS_GEMM = 147456;
constexpr int LDS_BYTES = LDS_GEMM + 64;
constexpr float LN_ALPHA = 1.189207115f;
constexpr float NEGBIG = -1.0e30f;
constexpr float MINIT = -1.0e9f;

struct TJob { const float* src; bf16_t* dst; int ld, col0, ncols, npad, K, tile0; };
constexpr int MAXJOBS = 24;
struct Params {
  const float* in[28];
  float* out;
  unsigned char* ws;
  TJob jobs[MAXJOBS];
  int njobs, ntiles_t, ntiles_early, pad0, ph_lo, ph_hi;
};

DI unsigned pack2(float a, float b) { f32x2 v = {a, b}; return __builtin_bit_cast(unsigned, __builtin_convertvector(v, bf2_t)); }
DI bf16_t f2bf(float a) { return (bf16_t)(pack2(a, 0.f) & 0xffffu); }
DI float sigmoidf_(float x) { return __builtin_amdgcn_rcpf(1.f + __builtin_amdgcn_exp2f(-1.44269504f * x)); }
DI float geluf_(float x) { return 0.5f * x * (1.f + erff(x * 0.70710678118f)); }
DI float bflo(unsigned w) { return __uint_as_float(w << 16); }
DI float bfhi(unsigned w) { return __uint_as_float(w & 0xffff0000u); }
DI int crow_(int i, int h) { return (i & 3) + 8 * (i >> 2) + 4 * h; }
DI u32x4 cvt8(f32x4 a, f32x4 b) { u32x4 r; r[0] = pack2(a[0], a[1]); r[1] = pack2(a[2], a[3]); r[2] = pack2(b[0], b[1]); r[3] = pack2(b[2], b[3]); return r; }
DI f32x16 zero16() { f32x16 z; for (int i = 0; i < 16; ++i) z[i] = 0.f; return z; }

template <int TM, int TN, bool DEEP = true, class AL, class BL>
DI void gemm_kloop(f32x16 (&acc)[TM][TN], const int nk, AL aload, BL bload, unsigned char* smem) {
  constexpr int BM = 128 * TM, BN = 64 * TN;
  constexpr int STAGE = (BM + BN) * 144;
  const int tid = threadIdx.x, lane = tid & 63, w = tid >> 6, wr = w >> 1, wc = w & 1, l32 = lane & 31, h = lane >> 5;
  u32x4 ra0[2 * TM], rb0[TN], ra1[2 * TM], rb1[TN];
#define GLOAD(RA, RB, KT) { _Pragma("unroll") for (int i = 0; i < 2 * TM; ++i) { int c = tid + i * NTHR; RA[i] = aload(c >> 3, (c & 7) * 8, (KT)); } \
                            _Pragma("unroll") for (int i = 0; i < TN; ++i) { int c = tid + i * NTHR; RB[i] = bload(c >> 3, (c & 7) * 8, (KT)); } }
#define LSTORE(RA, RB, ST) { unsigned char* dA_ = smem + (ST) * STAGE; \
                            _Pragma("unroll") for (int i = 0; i < 2 * TM; ++i) { int c = tid + i * NTHR; *(u32x4*)(dA_ + (c >> 3) * 144 + (c & 7) * 16) = RA[i]; } \
                            _Pragma("unroll") for (int i = 0; i < TN; ++i) { int c = tid + i * NTHR; *(u32x4*)(dA_ + BM * 144 + (c >> 3) * 144 + (c & 7) * 16) = RB[i]; } }
#define COMPUTE(ST) { const unsigned char* sA = smem + (ST) * STAGE; const unsigned char* sB = sA + BM * 144; \
    _Pragma("unroll") for (int ks = 0; ks < 4; ++ks) { bf16x8 a[TM], b[TN]; \
      _Pragma("unroll") for (int tm = 0; tm < TM; ++tm) a[tm] = *(const bf16x8*)(sA + (wr * TM * 32 + tm * 32 + l32) * 144 + (ks * 2 + h) * 16); \
      _Pragma("unroll") for (int tn = 0; tn < TN; ++tn) b[tn] = *(const bf16x8*)(sB + (wc * TN * 32 + tn * 32 + l32) * 144 + (ks * 2 + h) * 16); \
      _Pragma("unroll") for (int tm = 0; tm < TM; ++tm) _Pragma("unroll") for (int tn = 0; tn < TN; ++tn) acc[tm][tn] = MFMA(a[tm], b[tn], acc[tm][tn]); } }
  if (!DEEP) {
    GLOAD(ra0, rb0, 0);
    __syncthreads();
    LSTORE(ra0, rb0, 0);
    __syncthreads();
    for (int kt = 0; kt < nk; ++kt) {
      const int cur = kt & 1;
      if (kt + 1 < nk) GLOAD(ra0, rb0, kt + 1);
      COMPUTE(cur);
      if (kt + 1 < nk) LSTORE(ra0, rb0, cur ^ 1);
      __syncthreads();
    }
    return;
  }
  GLOAD(ra0, rb0, 0);
  if (nk > 1) GLOAD(ra1, rb1, 1);
  __syncthreads();
  LSTORE(ra0, rb0, 0);
  __syncthreads();
  for (int kt = 0; kt < nk; kt += 2) {
    if (kt + 2 < nk) GLOAD(ra0, rb0, kt + 2);
    COMPUTE(0);
    if (kt + 1 < nk) LSTORE(ra1, rb1, 1);
    __syncthreads();
    if (kt + 1 >= nk) break;
    if (kt + 3 < nk) GLOAD(ra1, rb1, kt + 3);
    COMPUTE(1);
    if (kt + 2 < nk) LSTORE(ra0, rb0, 0);
    __syncthreads();
  }
#undef GLOAD
#undef LSTORE
#undef COMPUTE
}
template <int TM, int TN, class F>
DI void gemm_epi(f32x16 (&acc)[TM][TN], F f) {
  const int tid = threadIdx.x, lane = tid & 63, w = tid >> 6, wr = w >> 1, wc = w & 1, l32 = lane & 31, h = lane >> 5;
#pragma unroll
  for (int tm = 0; tm < TM; ++tm)
#pragma unroll
    for (int tn = 0; tn < TN; ++tn)
#pragma unroll
      for (int g = 0; g < 4; ++g)
        f(wr * TM * 32 + tm * 32 + 8 * g + 4 * h, wc * TN * 32 + tn * 32 + l32, acc[tm][tn][4 * g], acc[tm][tn][4 * g + 1], acc[tm][tn][4 * g + 2], acc[tm][tn][4 * g + 3]);
}
template <int TM, int TN, class F>
DI void gemm_epi_rows(f32x16 (&acc)[TM][TN], unsigned char* smem, F f) {
  const int tid = threadIdx.x, lane = tid & 63, w = tid >> 6, wr = w >> 1, wc = w & 1, l32 = lane & 31, h = lane >> 5;
  constexpr int RS = TN * 32 + 4;
  float* st = (float*)smem + w * (32 * RS);
#pragma unroll
  for (int tm = 0; tm < TM; ++tm) {
#pragma unroll
    for (int tn = 0; tn < TN; ++tn)
#pragma unroll
      for (int i = 0; i < 16; ++i) st[crow_(i, h) * RS + tn * 32 + l32] = acc[tm][tn][i];
    __builtin_amdgcn_s_waitcnt(0xc07f);
    constexpr int C4 = TN * 8;
#pragma unroll
    for (int i = 0; i < (32 * C4) / 64; ++i) {
      const int idx = i * 64 + lane, row = idx / C4, c4 = idx % C4;
      const f32x4 v = *(const f32x4*)(st + row * RS + c4 * 4);
      f(wr * TM * 32 + tm * 32 + row, wc * TN * 32 + c4 * 4, v);
    }
    __builtin_amdgcn_s_waitcnt(0xc07f);
  }
}
template <int TM, int TN, class F>
DI void gemm_epi_cols(f32x16 (&acc)[TM][TN], unsigned char* smem, F f) {
  const int tid = threadIdx.x, lane = tid & 63, w = tid >> 6, wr = w >> 1, wc = w & 1, l32 = lane & 31, h = lane >> 5;
  constexpr int RS = TN * 32 + 4;
  float* st = (float*)smem + w * (32 * RS);
#pragma unroll
  for (int tm = 0; tm < TM; ++tm) {
#pragma unroll
    for (int tn = 0; tn < TN; ++tn)
#pragma unroll
      for (int i = 0; i < 16; ++i) st[crow_(i, h) * RS + tn * 32 + l32] = acc[tm][tn][i];
    __builtin_amdgcn_s_waitcnt(0xc07f);
#pragma unroll
    for (int i = 0; i < TN * 2; ++i) {
      const int idx = i * 64 + lane, col = idx % (TN * 32), rg = idx / (TN * 32);
      float v[8];
#pragma unroll
      for (int r = 0; r < 8; ++r) v[r] = st[(rg * 8 + r) * RS + col];
      f(wr * TM * 32 + tm * 32 + rg * 8, wc * TN * 32 + col, v);
    }
    __builtin_amdgcn_s_waitcnt(0xc07f);
  }
}
template <int TM, int TN>
DI void zero_acc(f32x16 (&acc)[TM][TN]) {
#pragma unroll
  for (int a = 0; a < TM; ++a)
#pragma unroll
    for (int b = 0; b < TN; ++b) acc[a][b] = zero16();
}
DI u32x4 ldg16(const bf16_t* p) { return *(const u32x4*)p; }

DI void transpose_tile(const Params& P, int tile, unsigned char* smem) {
  const int tid = threadIdx.x;
  float* tl = (float*)smem;
  int j = 0;
  while (j + 1 < P.njobs && P.jobs[j + 1].tile0 <= tile) ++j;
  const float* src = P.jobs[j].src; bf16_t* dst = P.jobs[j].dst;
  const int ld = P.jobs[j].ld, col0 = P.jobs[j].col0, ncols = P.jobs[j].ncols, K = P.jobs[j].K;
  const int lt = tile - P.jobs[j].tile0, nkt = K >> 6, nt = lt / nkt, k0 = (lt - nt * nkt) << 6;
  __syncthreads();
#pragma unroll
  for (int i = 0; i < 8; ++i) {
    int idx = tid + i * NTHR, kk = idx >> 6, nn = idx & 63, n = nt * 64 + nn;
    tl[kk * 65 + nn] = (n < ncols) ? src[(size_t)(k0 + kk) * ld + col0 + n] : 0.f;
  }
  __syncthreads();
#pragma unroll
  for (int i = 0; i < 4; ++i) {
    int idx = tid + i * NTHR, nn = idx >> 5, kp = idx & 31;
    *(unsigned*)(dst + (size_t)(nt * 64 + nn) * K + k0 + kp * 2) = pack2(tl[(kp * 2) * 65 + nn], tl[(kp * 2 + 1) * 65 + nn]);
  }
}
DI void phase_prep(const Params& P, unsigned char* smem) {
  const int tid = threadIdx.x;
  for (int tile = blockIdx.x; tile < P.ntiles_early; tile += gridDim.x) transpose_tile(P, tile, smem);
  {
    const float* x = P.in[0]; bf16_t* xb = (bf16_t*)(P.ws + WS_XB);
    for (size_t i = (size_t)blockIdx.x * NTHR + tid; i < (size_t)T * DM / 8; i += (size_t)gridDim.x * NTHR) {
      f32x4 a = *(const f32x4*)(x + i * 8), b = *(const f32x4*)(x + i * 8 + 4);
      *(u32x4*)(xb + i * 8) = cvt8(a, b);
    }
    for (int i = blockIdx.x * NTHR + tid; i < 2 * 16384 / 8; i += gridDim.x * NTHR) {
      const int which = i >> 11, e = (i & 2047) * 8;
      const float* s = P.in[20 + which] + e;
      *(u32x4*)((bf16_t*)(P.ws + (which ? SM_SK2 : SM_SK1)) + e) = cvt8(*(const f32x4*)s, *(const f32x4*)(s + 4));
    }
  }
  if (blockIdx.x < 16) {
    const int which = tid >> 8, n = tid & 255, kb = blockIdx.x * 128;
    const float* pos = P.in[3 + which]; const float* w1 = P.in[which ? 7 : 5];
    float s = 0.f;
    for (int k = kb; k < kb + 128; ++k) s += pos[k] * w1[(size_t)k * 256 + n];
    ((float*)(P.ws + SM_CBIAS))[blockIdx.x * 512 + tid] = s;
  }
  if (blockIdx.x == 16 && tid == 0) {
    float a = 0.f, b = 0.f;
    for (int i = 0; i < 64; ++i) { a += P.in[9][i] * P.in[10][i]; b += P.in[11][i] * P.in[12][i]; }
    *(float*)(P.ws + SM_LAM) = expf(a) - expf(b) + 0.2f;
  }
}

DI void phase_inproj(const Params& P, unsigned char* smem) {
  const bf16_t* xb = (const bf16_t*)(P.ws + WS_XB);
  const bf16_t* wt = (const bf16_t*)(P.ws + WS_WINR);
  bf16_t* proj = (bf16_t*)(P.ws + R_PROJ);
  bf16_t* vT = (bf16_t*)(P.ws + R_VT);
  const int wc = (threadIdx.x >> 6) & 1;
  for (int tile = blockIdx.x; tile < 64 * 12; tile += gridDim.x) {
    const int mt = tile / 12, nt = tile - mt * 12;
    const int m0 = mt * 256, n0 = nt * 256;
    f32x16 acc[2][4]; zero_acc(acc);
    gemm_kloop<2, 4, false>(acc, 16,
      [&](int r, int ko, int kt) { return ldg16(xb + (size_t)(m0 + r) * DM + kt * 64 + ko); },
      [&](int r, int ko, int kt) { return ldg16(wt + (size_t)min(n0 + r, 2943) * DM + kt * 64 + ko); }, smem);
    const int seg = nt * 2 + wc;
    if (seg < 17) {
      const float sc = (seg < 4 || (seg >= 8 && seg < 12)) ? 0.125f : 1.f;
      const bool sg = (seg == 16);
      gemm_epi_rows<2, 4>(acc, smem, [&](int m, int n, f32x4 v) {
        if (sg) { v[0] = sigmoidf_(v[0]); v[1] = sigmoidf_(v[1]); v[2] = sigmoidf_(v[2]); v[3] = sigmoidf_(v[3]); }
        else v *= sc;
        u32x2 o = {pack2(v[0], v[1]), pack2(v[2], v[3])};
        *(u32x2*)(proj + (size_t)(m0 + m) * PJ + n0 + n) = o;
      });
    } else if (seg < 23) {
      gemm_epi_cols<2, 4>(acc, smem, [&](int m, int n, const float (&v)[8]) {
        const int mm = m0 + m, b = mm >> 11, sq = mm & 2047, c = n0 + n - 2176;
        u32x4 o = {pack2(v[0], v[1]), pack2(v[2], v[3]), pack2(v[4], v[5]), pack2(v[6], v[7])};
        *(u32x4*)(vT + ((size_t)(b * 768 + c) * SEQ + sq)) = o;
      });
    }
  }
}

DI void cmp1_tile(const Params& P, int tile, unsigned char* smem) {
  const bf16_t* proj = (const bf16_t*)(P.ws + R_PROJ);
  bf16_t* hid = (bf16_t*)(P.ws + R_HID);
  const float* cb = (const float*)(P.ws + SM_CBIAS);
  {
    const int which = tile >> 4, mt = (tile >> 1) & 7, nt = tile & 1;
    const bf16_t* w1 = (const bf16_t*)(P.ws + (which ? WS_CW1V : WS_CW1K));
    const int colbase = which ? 896 : 512;
    f32x16 acc[2][2]; zero_acc(acc);
    gemm_kloop<2, 2>(acc, 32,
      [&](int r, int ko, int kt) {
        const int m = mt * 256 + r, bg = m >> 7, c = min(m & 127, 126), b = bg >> 1, g = bg & 1;
        return ldg16(proj + (size_t)(b * SEQ + c * 16 + kt) * PJ + colbase + g * 64 + ko); },
      [&](int r, int ko, int kt) { return ldg16(w1 + (size_t)(nt * 128 + r) * 2048 + kt * 64 + ko); }, smem);
    gemm_epi_rows<2, 2>(acc, smem, [&](int m, int n, f32x4 v) {
      const int nn = nt * 128 + n;
      f32x4 bias = {0.f, 0.f, 0.f, 0.f};
#pragma unroll
      for (int j = 0; j < 16; ++j) bias += *(const f32x4*)(cb + j * 512 + which * 256 + nn);
      v += bias;
      u32x2 o = {pack2(geluf_(v[0]), geluf_(v[1])), pack2(geluf_(v[2]), geluf_(v[3]))};
      *(u32x2*)(hid + ((size_t)which * 2048 + mt * 256 + m) * 256 + nn) = o;
    });
  }
}
DI void cmp2_tile(const Params& P, int tile, unsigned char* smem) {
  const bf16_t* hid = (const bf16_t*)(P.ws + R_HID);
  bf16_t* kc = (bf16_t*)(P.ws + R_KC);
  bf16_t* vcT = (bf16_t*)(P.ws + R_VCT);
  {
    const int which = tile >> 3, mt = tile & 7;
    const bf16_t* w2 = (const bf16_t*)(P.ws + (which ? SM_CW2V : SM_CW2K));
    f32x16 acc[2][1]; zero_acc(acc);
    gemm_kloop<2, 1>(acc, 4,
      [&](int r, int ko, int kt) { return ldg16(hid + ((size_t)which * 2048 + mt * 256 + r) * 256 + kt * 64 + ko); },
      [&](int r, int ko, int kt) { return ldg16(w2 + (size_t)r * 256 + kt * 64 + ko); }, smem);
    gemm_epi<2, 1>(acc, [&](int m, int n, float v0, float v1, float v2, float v3) {
      const int mm = mt * 256 + m, bg = mm >> 7, c = mm & 127;
      if (which == 0) {
        bf16_t* d = kc + ((size_t)bg * 128 + c) * 64 + n;
        d[0] = f2bf(v0); d[64] = f2bf(v1); d[128] = f2bf(v2); d[192] = f2bf(v3);
      } else {
        u32x2 v = {pack2(v0, v1), pack2(v2, v3)};
        *(u32x2*)(vcT + ((size_t)bg * 64 + n) * 128 + c) = v;
      }
    });
  }
}

DI void phase_cmp2(const Params& P, unsigned char* smem) {
  for (int tile = blockIdx.x; tile < 16; tile += gridDim.x) cmp2_tile(P, tile, smem);
}
DI int crow(int i, int h) { return (i & 3) + 8 * (i >> 2) + 4 * h; }
DI bf16x8 pack8(const f32x16& x, int s) {
  u32x4 p;
  p[0] = pack2(x[8 * s + 0], x[8 * s + 1]); p[1] = pack2(x[8 * s + 2], x[8 * s + 3]);
  p[2] = pack2(x[8 * s + 4], x[8 * s + 5]); p[3] = pack2(x[8 * s + 6], x[8 * s + 7]);
  return __builtin_bit_cast(bf16x8, p);
}
DI void qk64(f32x16* s, const unsigned char* sK, int rstride, const bf16x8 (&q)[4], int l32, int h) {
#pragma unroll
  for (int kt = 0; kt < 2; ++kt) {
    s[kt] = zero16();
#pragma unroll
    for (int ks = 0; ks < 4; ++ks) {
      bf16x8 a = *(const bf16x8*)(sK + (kt * 32 + l32) * rstride + (ks * 2 + h) * 16);
      s[kt] = MFMA(a, q[ks], s[kt]);
    }
  }
}
template <int NDV>
DI void pv64(f32x16 (&o)[NDV], const f32x16* p, const unsigned char* sV, int rstride, int kofs, int l32, int h) {
#pragma unroll
  for (int ks = 0; ks < 4; ++ks) {
    bf16x8 pb = pack8(p[ks >> 1], ks & 1);
#pragma unroll
    for (int dvt = 0; dvt < NDV; ++dvt) {
      const unsigned char* r = sV + (dvt * 32 + l32) * rstride + (kofs + ks * 16 + 4 * h) * 2;
      s16x4 lo = *(const s16x4*)r, hi = *(const s16x4*)(r + 16);
      bf16x8 a = __builtin_shufflevector(lo, hi, 0, 1, 2, 3, 4, 5, 6, 7);
      o[dvt] = MFMA(a, pb, o[dvt]);
    }
  }
}
template <int NDV>
DI void softmax64(f32x16 (&s)[2], float& m, float& l, f32x16 (&o)[NDV], int t, int kbase, float slope2, bool masked, bool sel, int hi, int h) {
  const float c0 = slope2 * (float)(kbase + 4 * h);
  const f32x2 B0 = {0.f, slope2}, B1 = {2.f * slope2, 3.f * slope2};
  const f32x2 L2 = {1.44269504f, 1.44269504f};
#pragma unroll
  for (int kt = 0; kt < 2; ++kt)
#pragma unroll
    for (int g = 0; g < 4; ++g) {
      const float A = fmaf(slope2, (float)(kt * 32 + 8 * g), c0);
      const f32x2 Av = {A, A};
      f32x2 v0 = {s[kt][4 * g], s[kt][4 * g + 1]}, v1 = {s[kt][4 * g + 2], s[kt][4 * g + 3]};
      v0 = __builtin_elementwise_fma(v0, L2, Av + B0);
      v1 = __builtin_elementwise_fma(v1, L2, Av + B1);
      s[kt][4 * g] = v0[0]; s[kt][4 * g + 1] = v0[1]; s[kt][4 * g + 2] = v1[0]; s[kt][4 * g + 3] = v1[1];
    }
  if (masked) {
    const int tr = t - kbase - 4 * h;
    const unsigned hie = sel ? (unsigned)hi : 0u;
#pragma unroll
    for (int kt = 0; kt < 2; ++kt)
#pragma unroll
      for (int i = 0; i < 16; ++i) {
        const int K = kt * 32 + (i & 3) + 8 * (i >> 2);
        s[kt][i] = ((unsigned)(tr - K) < hie) ? s[kt][i] : NEGBIG;
      }
  }
  float mx = NEGBIG;
#pragma unroll
  for (int kt = 0; kt < 2; ++kt)
#pragma unroll
    for (int i = 0; i < 16; i += 2) mx = fmaxf(fmaxf(s[kt][i], s[kt][i + 1]), mx);
  mx = fmaxf(mx, __shfl_xor(mx, 32));
  const bool need = mx > m + 8.f;
  if (__builtin_amdgcn_ballot_w64(need) != 0ull) {
    const float mn = need ? mx : m;
    const float alpha = __builtin_amdgcn_exp2f(m - mn);
    l *= alpha;
#pragma unroll
    for (int d = 0; d < NDV; ++d) o[d] *= alpha;
    m = mn;
  }
  const f32x2 mv = {m, m};
  f32x2 ls2 = {0.f, 0.f};
#pragma unroll
  for (int kt = 0; kt < 2; ++kt)
#pragma unroll
    for (int i = 0; i < 16; i += 2) {
      const f32x2 d = f32x2{s[kt][i], s[kt][i + 1]} - mv;
      const f32x2 e = {__builtin_amdgcn_exp2f(d[0]), __builtin_amdgcn_exp2f(d[1])};
      s[kt][i] = e[0]; s[kt][i + 1] = e[1];
      ls2 += e;
    }
  l += ls2[0] + ls2[1];
}

DI void nsa_item(const Params& P, int item, unsigned char* smem) {
  const int tid = threadIdx.x, lane = tid & 63, w = __builtin_amdgcn_readfirstlane(tid >> 6), l32 = lane & 31, h = lane >> 5;
  const int qb = item & 31, bg = item >> 5, b = bg >> 1, g = bg & 1;
  const int hw = w & 3, qt = w >> 2, head = g * 4 + hw;
  const int q64 = qt * 32 + l32, t = qb * 64 + q64;
  const size_t token = (size_t)b * SEQ + t;
  const float slope = exp2f(-(float)(head + 1));
  const float slope2 = slope * 1.44269504f;
  const bf16_t* proj = (const bf16_t*)(P.ws + R_PROJ);
  const bf16_t* vT = (const bf16_t*)(P.ws + R_VT);
  unsigned char* sK = smem;
  unsigned char* sV = smem + 18432;
  float* imp = (float*)(smem + 36864);
  unsigned* umask = (unsigned*)(smem + 36864 + 8448);

  bf16x8 q[4];
#pragma unroll
  for (int ks = 0; ks < 4; ++ks) q[ks] = *(const bf16x8*)(proj + token * PJ + head * 64 + ks * 16 + h * 8);
  const float g0 = __uint_as_float((unsigned)proj[token * PJ + 2048 + head * 3 + 0] << 16);
  const float g1 = __uint_as_float((unsigned)proj[token * PJ + 2048 + head * 3 + 1] << 16);
  const float g2 = __uint_as_float((unsigned)proj[token * PJ + 2048 + head * 3 + 2] << 16);

  __syncthreads();
  for (int i = tid; i < 64 * 33; i += NTHR) imp[i] = 0.f;
  if (tid == 0) *umask = 0u;
  {
    const bf16_t* kc = (const bf16_t*)(P.ws + R_KC) + (size_t)bg * 128 * 64;
    const bf16_t* vc = (const bf16_t*)(P.ws + R_VCT) + (size_t)bg * 64 * 128;
#pragma unroll
    for (int i = 0; i < 2; ++i) {
      int c = tid + i * NTHR;
      *(u32x4*)(sK + (c >> 3) * 144 + (c & 7) * 16) = ldg16(kc + (c >> 3) * 64 + (c & 7) * 8);
      *(u32x4*)(sV + (c >> 4) * 272 + (c & 15) * 16) = ldg16(vc + (c >> 4) * 128 + (c & 15) * 8);
    }
  }
  __syncthreads();
  f32x16 comb[2];
  {
    f32x16 sc[4];
    qk64(sc, sK, 144, q, l32, h);
    qk64(sc + 2, sK + 64 * 144, 144, q, l32, h);
    float mx = NEGBIG;
#pragma unroll
    for (int kt = 0; kt < 4; ++kt)
#pragma unroll
      for (int i = 0; i < 16; ++i) {
        const int c = kt * 32 + crow(i, h);
        const int dist = t - (c * 16 + 31);
        const float r = (dist >= 0) ? sc[kt][i] - slope * (float)dist : NEGBIG;
        sc[kt][i] = r;
        mx = fmaxf(mx, r);
      }
    mx = fmaxf(mx, __shfl_xor(mx, 32));
    float ls = 0.f;
#pragma unroll
    for (int kt = 0; kt < 4; ++kt)
#pragma unroll
      for (int i = 0; i < 16; ++i) {
        const float r = (sc[kt][i] > -1.0e29f) ? __expf(sc[kt][i] - mx) : 0.f;
        sc[kt][i] = r;
        ls += r;
      }
    ls += __shfl_xor(ls, 32);
    const float inv = 1.f / fmaxf(ls, 1.0e-30f);
#pragma unroll
    for (int kt = 0; kt < 4; ++kt)
#pragma unroll
      for (int gq = 0; gq < 4; ++gq) {
        const float p0 = sc[kt][4 * gq] * inv, p1 = sc[kt][4 * gq + 1] * inv, p2 = sc[kt][4 * gq + 2] * inv, p3 = sc[kt][4 * gq + 3] * inv;
        sc[kt][4 * gq] = p0; sc[kt][4 * gq + 1] = p1; sc[kt][4 * gq + 2] = p2; sc[kt][4 * gq + 3] = p3;
        const int j = 8 * kt + 2 * gq + h;
        const float sp = 0.5f * p3;
        atomicAdd(&imp[q64 * 33 + j], p0 + p1 + p2 + sp);
        atomicAdd(&imp[q64 * 33 + j + 1], sp);
      }
    f32x16 o[2]; o[0] = zero16(); o[1] = zero16();
    pv64<2>(o, sc, sV, 272, 0, l32, h);
    pv64<2>(o, sc + 2, sV, 272, 64, l32, h);
    comb[0] = o[0] * g0; comb[1] = o[1] * g0;
  }
  __syncthreads();
  const int cur = qb;
  unsigned mask = 1u | (1u << cur) | (cur >= 1 ? (1u << (cur - 1)) : 0u);
  {
    float tv[5]; int ti[5];
#pragma unroll
    for (int k = 0; k < 5; ++k) { tv[k] = -1.f; ti[k] = -1; }
    for (int j = 1; j <= cur - 2; ++j) {
      float v = imp[q64 * 33 + j]; int vi = j;
#pragma unroll
      for (int k = 0; k < 5; ++k) {
        const bool gt = v > tv[k];
        const float nv = gt ? tv[k] : v; const int ni = gt ? ti[k] : vi;
        tv[k] = gt ? v : tv[k]; ti[k] = gt ? vi : ti[k];
        v = nv; vi = ni;
      }
    }
#pragma unroll
    for (int k = 0; k < 5; ++k) if (ti[k] >= 0) mask |= (1u << ti[k]);
  }
  {
    unsigned um = mask;
#pragma unroll
    for (int off = 32; off >= 1; off >>= 1) um |= (unsigned)__shfl_xor((int)um, off);
    if (lane == 0) atomicOr(umask, um);
  }
  __syncthreads();
  const unsigned un = *umask;
#pragma unroll 1
  for (int br = 0; br < 2; ++br) {
    const int kcol = (br == 0 ? 640 : 768) + g * 64;
    const int vrow = (br == 0 ? 0 : 128) + g * 64;
    const int j0 = (br == 0) ? 0 : max(0, cur - 8);
    const int hi = (br == 0) ? 0x7fffffff : 512;
    const unsigned upto = (cur >= 31) ? 0xffffffffu : ((2u << cur) - 1u);
    unsigned tmask = (br == 0) ? (un & upto) : (upto & ~((1u << j0) - 1u));
    float m = MINIT, l = 0.f;
    f32x16 o[2]; o[0] = zero16(); o[1] = zero16();
    const int lr = tid >> 3, lpart = tid & 7;
    const bf16_t* kbase = proj + ((size_t)b * SEQ + lr) * PJ + kcol + lpart * 8;
    const bf16_t* vbase = vT + ((size_t)(b * 768 + vrow + lr) * SEQ + lpart * 8);
    u32x4 rk, rv;
    int j = __builtin_ctz(tmask); tmask &= tmask - 1;
    rk = ldg16(kbase + (size_t)j * 64 * PJ); rv = ldg16(vbase + j * 64);
    __syncthreads();
    *(u32x4*)(sK + lr * 144 + lpart * 16) = rk; *(u32x4*)(sK + 9216 + lr * 144 + lpart * 16) = rv;
    __syncthreads();
    int st = 0;
#pragma unroll 1
    while (true) {
      const bool more = (tmask != 0u);
      int jn = 0;
      if (more) { jn = __builtin_ctz(tmask); tmask &= tmask - 1; rk = ldg16(kbase + (size_t)jn * 64 * PJ); rv = ldg16(vbase + jn * 64); }
      const unsigned char* cK = sK + st * 18432;
      f32x16 sc2[2];
      qk64(sc2, cK, 144, q, l32, h);
      const bool sel = (br == 0) ? (((mask >> j) & 1u) != 0u) : true;
      const int tw0 = qb * 64 + qt * 32;
      const bool fast = (br == 0) ? (j < cur && __builtin_amdgcn_ballot_w64(!sel) == 0ull)
                                  : (j * 64 + 63 <= tw0 && j * 64 >= tw0 + 31 - 511);
      softmax64<2>(sc2, m, l, o, t, j * 64, slope2, !fast, sel, hi, h);
      pv64<2>(o, sc2, cK + 9216, 144, 0, l32, h);
      if (!more) break;
      unsigned char* nK = sK + (st ^ 1) * 18432;
      *(u32x4*)(nK + lr * 144 + lpart * 16) = rk; *(u32x4*)(nK + 9216 + lr * 144 + lpart * 16) = rv;
      __syncthreads();
      st ^= 1; j = jn;
    }
    l += __shfl_xor(l, 32);
    const float scl = (br == 0 ? g1 : g2) / fmaxf(l, 1.0e-30f);
    comb[0] += o[0] * scl; comb[1] += o[1] * scl;
  }
  bf16_t* on = (bf16_t*)(P.ws + R_ONSA) + token * 512 + head * 64;
#pragma unroll
  for (int dvt = 0; dvt < 2; ++dvt)
#pragma unroll
    for (int gq = 0; gq < 4; ++gq) {
      u32x2 v = {pack2(comb[dvt][4 * gq], comb[dvt][4 * gq + 1]), pack2(comb[dvt][4 * gq + 2], comb[dvt][4 * gq + 3])};
      *(u32x2*)(on + dvt * 32 + 8 * gq + 4 * h) = v;
    }
}

DI void diff_item(const Params& P, int item, unsigned char* smem) {
  const int tid = threadIdx.x, lane = tid & 63, w = __builtin_amdgcn_readfirstlane(tid >> 6), l32 = lane & 31, h = lane >> 5;
  const int qb = item & 15, bh = item >> 4, b = bh >> 2, head = bh & 3;
  const int map = w >> 2, qt = w & 3;
  const int t = qb * 128 + qt * 32 + l32;
  const size_t token = (size_t)b * SEQ + t;
  const float slope2 = exp2f(-2.f * (float)(head + 1)) * 1.44269504f;
  const bf16_t* proj = (const bf16_t*)(P.ws + R_PROJ);
  const bf16_t* vT = (const bf16_t*)(P.ws + R_VT);
  unsigned char* sK1 = smem; unsigned char* sK2 = smem + 9216; unsigned char* sV = smem + 18432;
  bf16x8 q[4];
#pragma unroll
  for (int ks = 0; ks < 4; ++ks) q[ks] = *(const bf16x8*)(proj + token * PJ + 1024 + map * 256 + head * 64 + ks * 16 + h * 8);
  float m = MINIT, l = 0.f;
  f32x16 o[4];
#pragma unroll
  for (int d = 0; d < 4; ++d) o[d] = zero16();
  const int tmax_w = qb * 128 + qt * 32 + 31;
  const int lr = tid >> 3, lpart = tid & 7;
  const bf16_t* kbase = proj + ((size_t)b * SEQ + lr) * PJ + 1536 + head * 64 + lpart * 8;
  const bf16_t* vbase0 = vT + ((size_t)(b * 768 + 256 + head * 128 + lr) * SEQ + lpart * 8);
  const bf16_t* vbase1 = vbase0 + (size_t)64 * SEQ;
  const int nj = 2 * qb + 2;
#pragma unroll 1
  for (int j = 0; j < nj; ++j) {
    __syncthreads();
    {
      const size_t ko = (size_t)j * 64 * PJ; const int vo = j * 64;
      const u32x4 rk1 = ldg16(kbase + ko), rk2 = ldg16(kbase + ko + 256), rv0 = ldg16(vbase0 + vo), rv1 = ldg16(vbase1 + vo);
      *(u32x4*)(sK1 + lr * 144 + lpart * 16) = rk1; *(u32x4*)(sK2 + lr * 144 + lpart * 16) = rk2;
      *(u32x4*)(sV + lr * 144 + lpart * 16) = rv0; *(u32x4*)(sV + (64 + lr) * 144 + lpart * 16) = rv1;
    }
    __syncthreads();
    if (j * 64 <= tmax_w) {
      f32x16 sc2[2];
      qk64(sc2, map ? sK2 : sK1, 144, q, l32, h);
      softmax64<4>(sc2, m, l, o, t, j * 64, slope2, !(j * 64 + 63 <= tmax_w - 31), true, 0x7fffffff, h);
      pv64<4>(o, sc2, sV, 144, 0, l32, h);
    }
  }
  l += __shfl_xor(l, 32);
  const float inv = 1.f / fmaxf(l, 1.0e-30f);
  __syncthreads();
  float* ex = (float*)smem;
  if (map == 1) {
#pragma unroll
    for (int d = 0; d < 4; ++d)
#pragma unroll
      for (int i = 0; i < 16; ++i) ex[(qt * 64 + d * 16 + i) * 64 + lane] = o[d][i] * inv;
  }
  __syncthreads();
  if (map == 0) {
    const float lam = __uint_as_float(__hip_atomic_load((const unsigned*)(P.ws + SM_LAM), __ATOMIC_RELAXED, __HIP_MEMORY_SCOPE_AGENT));
    float ss = 0.f;
#pragma unroll
    for (int d = 0; d < 4; ++d)
#pragma unroll
      for (int i = 0; i < 16; ++i) {
        const float v = o[d][i] * inv - lam * ex[(qt * 64 + d * 16 + i) * 64 + lane];
        o[d][i] = v; ss += v * v;
      }
    ss += __shfl_xor(ss, 32);
    const float r = rsqrtf(ss * (1.f / 128.f) + 1.0e-5f) * 0.8f;
    const float* ng = P.in[13];
    bf16_t* od = (bf16_t*)(P.ws + R_ODIFF) + token * 512 + head * 128;
#pragma unroll
    for (int d = 0; d < 4; ++d)
#pragma unroll
      for (int gq = 0; gq < 4; ++gq) {
        const int dv = d * 32 + 8 * gq + 4 * h;
        const f32x4 gg = *(const f32x4*)(ng + dv);
        u32x2 v = {pack2(o[d][4 * gq] * r * gg[0], o[d][4 * gq + 1] * r * gg[1]), pack2(o[d][4 * gq + 2] * r * gg[2], o[d][4 * gq + 3] * r * gg[3])};
        *(u32x2*)(od + dv) = v;
      }
  }
}

DI void fp8_conv_item(const Params& P, int item);
#ifndef ATTN_SEL
#define ATTN_SEL 3
#endif
DI void phase_queue(const Params& P, unsigned char* smem, unsigned* qctr, const bool dyn) {
  const int ng = (P.ntiles_t - P.ntiles_early + 7) >> 3;
  const int nm = 512 + ng;
  const int total = 32 + 512 + nm;
  unsigned* done = qctr + 8;
  volatile int* sidx = (volatile int*)(smem + LDS_GEMM + 32);
  int idx = blockIdx.x;
  while (true) {
    if (dyn) {
      __syncthreads();
      if (threadIdx.x == 0) *sidx = (int)__hip_atomic_fetch_add(qctr, 1u, __ATOMIC_RELAXED, __HIP_MEMORY_SCOPE_AGENT);
      __syncthreads();
      idx = *sidx;
    }
    if (idx >= total) break;
    if (idx < 32) {
      cmp1_tile(P, idx, smem);
      if (dyn) {
        asm volatile("s_waitcnt vmcnt(0)" ::: "memory");
        __syncthreads();
        if (threadIdx.x == 0) {
          __builtin_amdgcn_fence(__ATOMIC_RELEASE, "agent");
          asm volatile("s_waitcnt vmcnt(0)" ::: "memory");
          __hip_atomic_fetch_add(&done[(idx >> 4) * 8 + ((idx >> 1) & 7)], 1u, __ATOMIC_RELAXED, __HIP_MEMORY_SCOPE_AGENT);
        }
      }
    } else {
      const int j = idx - 32;
      int kind, it;
      if (j < 1024) { kind = j & 1; it = j >> 1; } else { kind = 1; it = j - 512; }
      if (kind == 0) {
        if (ATTN_SEL & 1) { const int bh = it & 31, qb = 15 - (it >> 5); diff_item(P, bh * 16 + qb, smem); }
      } else if (it < 512) fp8_conv_item(P, it);
      else {
        const int t0 = P.ntiles_early + (it - 512) * 8;
        for (int tt = t0; tt < min(t0 + 8, P.ntiles_t); ++tt) transpose_tile(P, tt, smem);
      }
    }
    if (!dyn) idx += gridDim.x;
  }
  asm volatile("" ::: "memory");
  if (dyn && blockIdx.x < 16) {
    const int ct = blockIdx.x;
    if (threadIdx.x == 0) {
      unsigned sp = 0;
      while (__hip_atomic_load(&done[ct], __ATOMIC_RELAXED, __HIP_MEMORY_SCOPE_AGENT) < 2u) { __builtin_amdgcn_s_sleep(2); if (++sp > (1u << 22)) break; }
      __builtin_amdgcn_fence(__ATOMIC_ACQUIRE, "agent");
      asm volatile("s_waitcnt vmcnt(0)" ::: "memory");
    }
    __syncthreads();
    cmp2_tile(P, ct, smem);
    asm volatile("s_waitcnt vmcnt(0)" ::: "memory");
    __syncthreads();
    if (threadIdx.x == 0) {
      __builtin_amdgcn_fence(__ATOMIC_RELEASE, "agent");
      asm volatile("s_waitcnt vmcnt(0)" ::: "memory");
      __hip_atomic_fetch_add(&done[16 + ct], 1u, __ATOMIC_RELAXED, __HIP_MEMORY_SCOPE_AGENT);
    }
  }
}
DI void phase_nsa(const Params& P, unsigned char* smem, unsigned* qctr, const unsigned* done3, const bool dyn) {
  volatile int* sidx = (volatile int*)(smem + LDS_GEMM + 32);
  int idx = blockIdx.x;
  if (!(ATTN_SEL & 2)) return;
  while (true) {
    if (dyn) {
      __syncthreads();
      if (threadIdx.x == 0) *sidx = (int)__hip_atomic_fetch_add(qctr, 1u, __ATOMIC_RELAXED, __HIP_MEMORY_SCOPE_AGENT);
      __syncthreads();
      idx = *sidx;
    }
    if (idx >= 512) break;
    const int bg = idx & 15, qb = 31 - (idx >> 4);
    if (dyn) {
      if (threadIdx.x == 0) {
        unsigned sp = 0;
        while (__hip_atomic_load(&done3[bg >> 1], __ATOMIC_RELAXED, __HIP_MEMORY_SCOPE_AGENT) < 1u ||
               __hip_atomic_load(&done3[8 + (bg >> 1)], __ATOMIC_RELAXED, __HIP_MEMORY_SCOPE_AGENT) < 1u) { __builtin_amdgcn_s_sleep(2); if (++sp > (1u << 22)) break; }
        __builtin_amdgcn_fence(__ATOMIC_ACQUIRE, "agent");
        asm volatile("s_waitcnt vmcnt(0)" ::: "memory");
      }
      __syncthreads();
    }
    nsa_item(P, bg * 32 + qb, smem);
    if (!dyn) idx += gridDim.x;
  }
}

DI void phase_merge(const Params& P, unsigned char* smem) {
  const bf16_t* xb = (const bf16_t*)(P.ws + WS_XB);
  const bf16_t* wg = (const bf16_t*)(P.ws + WS_WGATE);
  const bf16_t* wbn = (const bf16_t*)(P.ws + WS_WBN);
  const bf16_t* wbd = (const bf16_t*)(P.ws + WS_WBD);
  const bf16_t* onsa = (const bf16_t*)(P.ws + R_ONSA);
  const bf16_t* odiff = (const bf16_t*)(P.ws + R_ODIFF);
  bf16_t* merged = (bf16_t*)(P.ws + R_MERGED);
#pragma unroll 1
  for (int tile = blockIdx.x; tile < 64 * 8; tile += gridDim.x) {
    const int mt = tile >> 3, nt = tile & 7, m0 = mt * 256, n0 = nt * 128;
    unsigned resp[2][2][8];
    unsigned gp[2][2][8];
    f32x16 va[2][2];
#pragma unroll
    for (int br = 0; br < 2; ++br) {
      zero_acc(va);
      const bf16_t* wgb = wg + (size_t)br * 1024 * DM;
      gemm_kloop<2, 2, false>(va, 16,
        [&](int r, int ko, int kt) { return ldg16(xb + (size_t)(m0 + r) * DM + kt * 64 + ko); },
        [&](int r, int ko, int kt) { return ldg16(wgb + (size_t)(n0 + r) * DM + kt * 64 + ko); }, smem);
#pragma unroll
      for (int tm = 0; tm < 2; ++tm)
#pragma unroll
        for (int tn = 0; tn < 2; ++tn)
#pragma unroll
          for (int i = 0; i < 8; ++i) gp[tm][tn][i] = pack2(sigmoidf_(va[tm][tn][2 * i]), sigmoidf_(va[tm][tn][2 * i + 1]));
      zero_acc(va);
      const bf16_t* oa = br ? odiff : onsa; const bf16_t* wb = br ? wbd : wbn;
      gemm_kloop<2, 2, false>(va, 8,
        [&](int r, int ko, int kt) { return ldg16(oa + (size_t)(m0 + r) * 512 + kt * 64 + ko); },
        [&](int r, int ko, int kt) { return ldg16(wb + (size_t)(n0 + r) * 512 + kt * 64 + ko); }, smem);
#pragma unroll
      for (int tm = 0; tm < 2; ++tm)
#pragma unroll
        for (int tn = 0; tn < 2; ++tn)
#pragma unroll
          for (int i = 0; i < 8; ++i) {
            const float p0 = bflo(gp[tm][tn][i]) * va[tm][tn][2 * i], p1 = bfhi(gp[tm][tn][i]) * va[tm][tn][2 * i + 1];
            if (br == 0) resp[tm][tn][i] = pack2(p0, p1);
            else { va[tm][tn][2 * i] = bflo(resp[tm][tn][i]) + p0; va[tm][tn][2 * i + 1] = bfhi(resp[tm][tn][i]) + p1; }
          }
    }
    gemm_epi_rows<2, 2>(va, smem, [&](int m, int n, f32x4 v) {
      u32x2 o = {pack2(v[0], v[1]), pack2(v[2], v[3])};
      *(u32x2*)(merged + (size_t)(m0 + m) * DM + n0 + n) = o;
    });
  }
}
DI void phase_outproj(const Params& P, unsigned char* smem) {
  const bf16_t* merged = (const bf16_t*)(P.ws + R_MERGED);
  const bf16_t* wo = (const bf16_t*)(P.ws + WS_WOUT);
  const float* x = P.in[0];
  for (int tile = blockIdx.x; tile < 64 * 8; tile += gridDim.x) {
    const int mt = tile >> 3, nt = tile & 7, m0 = mt * 256, n0 = nt * 128;
    f32x16 acc[2][2]; zero_acc(acc);
    gemm_kloop<2, 2>(acc, 16,
      [&](int r, int ko, int kt) { return ldg16(merged + (size_t)(m0 + r) * DM + kt * 64 + ko); },
      [&](int r, int ko, int kt) { return ldg16(wo + (size_t)(n0 + r) * DM + kt * 64 + ko); }, smem);
    gemm_epi_rows<2, 2>(acc, smem, [&](int m, int n, f32x4 v) {
      const size_t o = (size_t)(m0 + m) * DM + n0 + n;
      const f32x4 xv = *(const f32x4*)(x + o);
      *(f32x4*)(P.out + o) = xv * LN_ALPHA + v;
    });
  }
}
DI float wave_sum(float v) {
#pragma unroll
  for (int off = 32; off >= 1; off >>= 1) v += __shfl_xor(v, off);
  return v;
}
DI void phase_ln1(const Params& P) {
  const int tid = threadIdx.x, lane = tid & 63, w = tid >> 6;
  const float* gam = P.in[17]; const float* bet = P.in[18];
  bf16_t* hb = (bf16_t*)(P.ws + WS_XB);
  for (int row = blockIdx.x * 8 + w; row < T; row += gridDim.x * 8) {
    const float* r = P.out + (size_t)row * DM;
    f32x4 v[4];
    v[0] = *(const f32x4*)(r + lane * 8); v[1] = *(const f32x4*)(r + lane * 8 + 4); v[2] = *(const f32x4*)(r + 512 + lane * 8); v[3] = *(const f32x4*)(r + 512 + lane * 8 + 4);
    float s = 0.f;
#pragma unroll
    for (int i = 0; i < 4; ++i) s += v[i][0] + v[i][1] + v[i][2] + v[i][3];
    const float mu = wave_sum(s) * (1.f / 1024.f);
    float ss = 0.f;
#pragma unroll
    for (int i = 0; i < 4; ++i)
#pragma unroll
      for (int k = 0; k < 4; ++k) { const float d = v[i][k] - mu; ss += d * d; }
    const float rs = rsqrtf(wave_sum(ss) * (1.f / 1024.f) + 1.0e-5f);
#pragma unroll
    for (int i = 0; i < 4; ++i) {
      const int c = (i >> 1) * 512 + lane * 8 + (i & 1) * 4;
      const f32x4 gg = *(const f32x4*)(gam + c), bb = *(const f32x4*)(bet + c);
#pragma unroll
      for (int k = 0; k < 4; ++k) v[i][k] = (v[i][k] - mu) * rs * gg[k] + bb[k];
    }
    *(u32x4*)(hb + (size_t)row * DM + lane * 8) = cvt8(v[0], v[1]);
    *(u32x4*)(hb + (size_t)row * DM + 512 + lane * 8) = cvt8(v[2], v[3]);
  }
}

DI void fp8_conv_item(const Params& P, int item) {
  const int tid = threadIdx.x, lane = tid & 63, w = tid >> 6;
  for (int rr_ = 0; rr_ < 8; ++rr_) {
    const int row = item * 64 + w * 8 + rr_;
    const int which = row >> 14, rr = row & 16383;
    const float* sp = P.in[22 + which] + (size_t)rr * DM + lane * 16;
    f32x4 a[4];
#pragma unroll
    for (int i = 0; i < 4; ++i) a[i] = *(const f32x4*)(sp + i * 4);
    float mx = 0.f;
#pragma unroll
    for (int i = 0; i < 4; ++i)
#pragma unroll
      for (int k = 0; k < 4; ++k) mx = fmaxf(mx, fabsf(a[i][k]));
#pragma unroll
    for (int off = 32; off >= 1; off >>= 1) mx = fmaxf(mx, __shfl_xor(mx, off));
    const float sc = mx > 0.f ? 256.f / mx : 1.f;
    u32x4 o;
#pragma unroll
    for (int i = 0; i < 4; ++i) {
      int wd = 0;
      wd = __builtin_amdgcn_cvt_pk_fp8_f32(a[i][0] * sc, a[i][1] * sc, wd, false);
      wd = __builtin_amdgcn_cvt_pk_fp8_f32(a[i][2] * sc, a[i][3] * sc, wd, true);
      o[i] = (unsigned)wd;
    }
    *(u32x4*)(P.ws + (which ? R_VB8 : R_UB8) + (size_t)rr * 1024 + lane * 16) = o;
    if (lane == 0) ((float*)(P.ws + R_USC))[row] = mx > 0.f ? mx * (1.f / 256.f) : 1.f;
  }
}

DI void bubble16(float (&tv)[16], float v) {
#pragma unroll
  for (int k = 0; k < 16; ++k) { const float hi = fmaxf(tv[k], v); v = fminf(tv[k], v); tv[k] = hi; }
}
DI void ce_desc(float& a, float& b) { const float hi = fmaxf(a, b), lo = fminf(a, b); a = hi; b = lo; }
DI void bitonic_merge16_desc(float (&v)[16]) {
#pragma unroll
  for (int j = 8; j > 0; j >>= 1)
#pragma unroll
    for (int i = 0; i < 16; ++i) { const int l = i ^ j; if (l > i) ce_desc(v[i], v[l]); }
}
DI void sort16_desc(float (&v)[16]) {
#pragma unroll
  for (int k = 2; k <= 16; k <<= 1)
#pragma unroll
    for (int j = k >> 1; j > 0; j >>= 1)
#pragma unroll
      for (int i = 0; i < 16; ++i) { const int l = i ^ j; if (l > i) { if ((i & k) == 0) ce_desc(v[i], v[l]); else ce_desc(v[l], v[i]); } }
}
DI void merge_top16(float (&tv)[16], const float (&nv)[16]) {
#pragma unroll
  for (int i = 0; i < 16; ++i) tv[i] = fmaxf(tv[i], nv[15 - i]);
  bitonic_merge16_desc(tv);
}
DI void phase_route(const Params& P, unsigned char* smem) {
  const int tid = threadIdx.x, lane = tid & 63, w = tid >> 6, l32 = lane & 31, h = lane >> 5;
  const bf16_t* hb = (const bf16_t*)(P.ws + WS_XB);
  const bf16_t* wq = (const bf16_t*)(P.ws + WS_WQ);
  u32x2* rec = (u32x2*)(P.ws + R_EID);
  unsigned char* idxb = smem + 110592 + tid * 32;
  for (int tile = blockIdx.x; tile < 64 * 8; tile += gridDim.x) {
    const int mt = tile >> 3, hd = tile & 7, m0 = mt * 256;
    float top[2][16];
#pragma unroll
    for (int half = 0; half < 2; ++half) {
      const int n0 = hd * 256 + half * 128;
      f32x16 acc[2][2]; zero_acc(acc);
      gemm_kloop<2, 2>(acc, 16,
        [&](int r, int ko, int kt) { return ldg16(hb + (size_t)(m0 + r) * DM + kt * 64 + ko); },
        [&](int r, int ko, int kt) { return ldg16(wq + (size_t)(n0 + r) * DM + kt * 64 + ko); }, smem);
      gemm_epi<2, 2>(acc, [&](int m, int n, float v0, float v1, float v2, float v3) {
        bf16_t* d = (bf16_t*)smem + m * 136 + n;
        d[0] = f2bf(v0); d[136] = f2bf(v1); d[272] = f2bf(v2); d[408] = f2bf(v3);
      });
      {
        const bf16_t* sk = (const bf16_t*)(P.ws + (half ? SM_SK2 : SM_SK1));
#pragma unroll
        for (int i = 0; i < 4; ++i) {
          const int c = tid + i * NTHR;
          *(u32x4*)(smem + 69632 + (c >> 4) * 272 + (c & 15) * 16) = ldg16(sk + (c >> 4) * 128 + (c & 15) * 8);
        }
      }
      __syncthreads();
      float tv[16];
#pragma unroll
      for (int k = 0; k < 16; ++k) tv[k] = -3.0e38f;
#pragma unroll 1
      for (int ktp = 0; ktp < 2; ++ktp) {
        f32x16 st[2]; st[0] = zero16(); st[1] = zero16();
#pragma unroll 2
        for (int ks = 0; ks < 8; ++ks) {
          const bf16x8 qf = *(const bf16x8*)(smem + (w * 32 + l32) * 272 + (ks * 2 + h) * 16);
#pragma unroll
          for (int kk = 0; kk < 2; ++kk) {
            const bf16x8 a = *(const bf16x8*)(smem + 69632 + ((ktp * 2 + kk) * 32 + l32) * 272 + (ks * 2 + h) * 16);
            st[kk] = MFMA(a, qf, st[kk]);
          }
        }
#pragma unroll
        for (int kk = 0; kk < 2; ++kk) {
          float gsort[16];
#pragma unroll
          for (int i = 0; i < 16; ++i) {
            const unsigned key = (unsigned)((ktp * 2 + kk) * 32 + crow(i, h));
            gsort[i] = __uint_as_float((__float_as_uint(st[kk][i]) & ~127u) | key);
          }
          sort16_desc(gsort);
          merge_top16(tv, gsort);
        }
      }
      float pv[16];
#pragma unroll
      for (int k = 0; k < 16; ++k) pv[k] = __shfl_xor(tv[k], 32);
      merge_top16(tv, pv);
#pragma unroll
      for (int k = 0; k < 16; ++k) top[half][k] = tv[k];
    }
#pragma unroll
    for (int k = 0; k < 16; ++k) { idxb[k] = (unsigned char)(__float_as_uint(top[0][k]) & 127u); idxb[16 + k] = (unsigned char)(__float_as_uint(top[1][k]) & 127u); }
    float tv[16];
#pragma unroll
    for (int k = 0; k < 16; ++k) tv[k] = -3.0e38f;
#pragma unroll
    for (int a = 0; a < 16; ++a)
#pragma unroll
      for (int bb = 0; bb < 16; ++bb)
        if ((a + 1) * (bb + 1) <= 16) {
          const float sum = __uint_as_float(__float_as_uint(top[0][a]) & ~127u) + __uint_as_float(__float_as_uint(top[1][bb]) & ~127u);
          bubble16(tv, __uint_as_float((__float_as_uint(sum) & ~255u) | (unsigned)(a * 16 + bb)));
        }
    float e[16], es = 0.f;
    const float mx = __uint_as_float(__float_as_uint(tv[0]) & ~255u);
#pragma unroll
    for (int k = 0; k < 16; ++k) { e[k] = __expf(__uint_as_float(__float_as_uint(tv[k]) & ~255u) - mx); es += e[k]; }
    const float inv = 1.f / es;
    if (h == 0) {
      const size_t base = ((size_t)(m0 + w * 32 + l32) * 8 + hd) * 16;
#pragma unroll
      for (int k = 0; k < 16; ++k) {
        const unsigned code = __float_as_uint(tv[k]) & 255u;
        u32x2 rc = {(unsigned)idxb[code >> 4] * 128u + (unsigned)idxb[16 + (code & 15)], __float_as_uint(e[k] * inv)};
        rec[base + k] = rc;
      }
    }
    __syncthreads();
  }
}

template <int TK>
DI void gather_batch(const unsigned char* ub, const unsigned char* vb, const float* usc, const float* vsc, const u32x2* srt,
                     int base, int n, const f32x2 (&x)[8], f32x2 (&acc)[8], int lane, int sub, bool b5, bool b4, bool b3) {
#pragma unroll 1
  for (int i = 0; i < n; i += 8) {
    const bool valid = (i + sub) < n;
    const u32x2 rc = srt[base + (valid ? i + sub : i)];
    const int my_e = (int)rc[0];
    const float gate = valid ? __uint_as_float(rc[1]) : 0.f;
    u32x4 ur[8], vr[8];
#pragma unroll
    for (int e = 0; e < 8; ++e) {
      const int id = __builtin_amdgcn_readlane(my_e, 8 * e);
      ur[e] = *(const u32x4*)(ub + (size_t)id * 1024 + lane * 16);
    }
#pragma unroll
    for (int e = 0; e < 8; ++e) {
      const int id = __builtin_amdgcn_readlane(my_e, 8 * e);
      vr[e] = *(const u32x4*)(vb + (size_t)id * 1024 + lane * 16);
    }
    const float su = usc[my_e], sv = vsc[my_e];
    float d[8];
#pragma unroll
    for (int e = 0; e < 8; ++e) {
      f32x2 sacc = f32x2{0.f, 0.f};
#pragma unroll
      for (int k = 0; k < 4; ++k) {
        sacc = __builtin_elementwise_fma(__builtin_amdgcn_cvt_pk_f32_fp8((int)ur[e][k], false), x[2 * k], sacc);
        sacc = __builtin_elementwise_fma(__builtin_amdgcn_cvt_pk_f32_fp8((int)ur[e][k], true), x[2 * k + 1], sacc);
      }
      d[e] = sacc[0] + sacc[1];
    }
    float r4[4], r2[2];
#pragma unroll
    for (int k = 0; k < 4; ++k) { const float keep = b5 ? d[k + 4] : d[k], send = b5 ? d[k] : d[k + 4]; r4[k] = keep + __shfl_xor(send, 32); }
#pragma unroll
    for (int k = 0; k < 2; ++k) { const float keep = b4 ? r4[k + 2] : r4[k], send = b4 ? r4[k] : r4[k + 2]; r2[k] = keep + __shfl_xor(send, 16); }
    float r1;
    { const float keep = b3 ? r2[1] : r2[0], send = b3 ? r2[0] : r2[1]; r1 = keep + __shfl_xor(send, 8); }
    r1 += __shfl_xor(r1, 4); r1 += __shfl_xor(r1, 2); r1 += __shfl_xor(r1, 1);
    const float wv = gate * geluf_(r1 * su) * sv;
#pragma unroll
    for (int e = 0; e < 8; ++e) {
      const float wt = __builtin_bit_cast(float, __builtin_amdgcn_readlane(__builtin_bit_cast(int, wv), 8 * e));
      const f32x2 w2 = f32x2{wt, wt};
#pragma unroll
      for (int k = 0; k < 4; ++k) {
        acc[2 * k] = __builtin_elementwise_fma(__builtin_amdgcn_cvt_pk_f32_fp8((int)vr[e][k], false), w2, acc[2 * k]);
        acc[2 * k + 1] = __builtin_elementwise_fma(__builtin_amdgcn_cvt_pk_f32_fp8((int)vr[e][k], true), w2, acc[2 * k + 1]);
      }
    }
  }
}
DI void phase_gather(const Params& P, unsigned char* smem) {
  const int tid = threadIdx.x, lane = tid & 63, w = __builtin_amdgcn_readfirstlane(tid >> 6);
  const unsigned char* ub = P.ws + R_UB8;
  const unsigned char* vb = P.ws + R_VB8;
  const float* usc = (const float*)(P.ws + R_USC);
  const float* vsc = (const float*)(P.ws + R_VSC);
  const float* gam = P.in[24]; const float* bet = P.in[25];
  bf16_t* hb = (bf16_t*)(P.ws + WS_XB);
  const int sub = (lane >> 3) & 7;
  const bool b5 = (lane & 32) != 0, b4 = (lane & 16) != 0, b3 = (lane & 8) != 0;
  unsigned char* wbase = smem + w * 5120;
  u32x2* srt = (u32x2*)wbase;
  int* cnt = (int*)(wbase + 4096);
  int* off = (int*)(wbase + 4096 + 256);
  int* cur = (int*)(wbase + 4096 + 512);
  __syncthreads();
  for (int grp = blockIdx.x * 8 + w; grp < T / 4; grp += gridDim.x * 8) {
    const int tok0 = grp * 4;
    f32x2 x[4][8], acc[4][8];
#pragma unroll
    for (int tk = 0; tk < 4; ++tk) {
      const u32x2* rec = (const u32x2*)(P.ws + R_EID) + (size_t)(tok0 + tk) * 128;
      const u32x2 r0 = rec[lane], r1 = rec[64 + lane];
      if (lane < 16) cnt[tk * 16 + lane] = 0;
      const int c0 = (int)(r0[0] >> 11), c1 = (int)(r1[0] >> 11);
      atomicAdd(&cnt[tk * 16 + c0], 1); atomicAdd(&cnt[tk * 16 + c1], 1);
      if (lane < 16) {
        int sacc = 0;
        for (int j = 0; j < 16; ++j) sacc += (j < lane) ? cnt[tk * 16 + j] : 0;
        off[tk * 16 + lane] = sacc; cur[tk * 16 + lane] = sacc;
      }
      const int p0 = atomicAdd(&cur[tk * 16 + c0], 1);
      srt[tk * 128 + p0] = r0;
      const int p1 = atomicAdd(&cur[tk * 16 + c1], 1);
      srt[tk * 128 + p1] = r1;
      const float* rin = P.out + (size_t)(tok0 + tk) * DM + lane * 16;
      {
        f32x4 a[4];
#pragma unroll
        for (int i = 0; i < 4; ++i) a[i] = *(const f32x4*)(rin + i * 4);
        float s1 = 0.f;
#pragma unroll
        for (int i = 0; i < 4; ++i) s1 += a[i][0] + a[i][1] + a[i][2] + a[i][3];
        const float mu1 = wave_sum(s1) * (1.f / 1024.f);
        float s2 = 0.f;
#pragma unroll
        for (int i = 0; i < 4; ++i)
#pragma unroll
          for (int k = 0; k < 4; ++k) { const float dd = a[i][k] - mu1; s2 += dd * dd; }
        const float rs1 = rsqrtf(wave_sum(s2) * (1.f / 1024.f) + 1.0e-5f);
#pragma unroll
        for (int i = 0; i < 4; ++i) {
          const f32x4 gg = *(const f32x4*)(P.in[17] + lane * 16 + i * 4), bb = *(const f32x4*)(P.in[18] + lane * 16 + i * 4);
#pragma unroll
          for (int k = 0; k < 4; ++k) a[i][k] = (a[i][k] - mu1) * rs1 * gg[k] + bb[k];
          x[tk][2 * i] = f32x2{a[i][0], a[i][1]}; x[tk][2 * i + 1] = f32x2{a[i][2], a[i][3]};
        }
      }
#pragma unroll
      for (int k = 0; k < 8; ++k) acc[tk][k] = f32x2{0.f, 0.f};
    }
    __builtin_amdgcn_s_waitcnt(0xc07f);
#pragma unroll 1
    for (int c = 0; c < 8; ++c) {
#pragma unroll
      for (int tk = 0; tk < 4; ++tk) {
        const int n = __builtin_amdgcn_readfirstlane(cnt[tk * 16 + c]);
        const int base = __builtin_amdgcn_readfirstlane(off[tk * 16 + c]);
        gather_batch<0>(ub, vb, usc, vsc, srt + tk * 128, base, n, x[tk], acc[tk], lane, sub, b5, b4, b3);
      }
    }
#pragma unroll
    for (int tk = 0; tk < 4; ++tk) {
      float* r = P.out + (size_t)(tok0 + tk) * DM + lane * 16;
      float y[16];
      float s = 0.f;
#pragma unroll
      for (int k = 0; k < 8; ++k) { y[2 * k] = acc[tk][k][0] + LN_ALPHA * x[tk][k][0]; y[2 * k + 1] = acc[tk][k][1] + LN_ALPHA * x[tk][k][1]; s += y[2 * k] + y[2 * k + 1]; }
      const float mu = wave_sum(s) * (1.f / 1024.f);
      float ss = 0.f;
#pragma unroll
      for (int k = 0; k < 16; ++k) { const float dd = y[k] - mu; ss += dd * dd; }
      const float rs = rsqrtf(wave_sum(ss) * (1.f / 1024.f) + 1.0e-5f);
      f32x4 o[4];
#pragma unroll
      for (int i = 0; i < 4; ++i) {
        const int cc = lane * 16 + i * 4;
        const f32x4 gg = *(const f32x4*)(gam + cc), bb = *(const f32x4*)(bet + cc);
#pragma unroll
        for (int k = 0; k < 4; ++k) o[i][k] = (y[i * 4 + k] - mu) * rs * gg[k] + bb[k];
        *(f32x4*)(r + i * 4) = o[i];
      }
      *(u32x4*)(hb + (size_t)(tok0 + tk) * DM + lane * 16) = cvt8(o[0], o[1]);
      *(u32x4*)(hb + (size_t)(tok0 + tk) * DM + lane * 16 + 8) = cvt8(o[2], o[3]);
    }
  }
}

DI void phase_final(const Params& P, unsigned char* smem, const bool dry) {
  const bf16_t* hb = (const bf16_t*)(P.ws + WS_XB);
  const bf16_t* wpg = (const bf16_t*)(P.ws + WS_WPG);
  const bf16_t* wpp = (const bf16_t*)(P.ws + WS_WPP);
  const float* pp = P.in[1];
  for (int tile = blockIdx.x; tile < 64 * 8; tile += gridDim.x) {
    const int mt = tile >> 3, nt = tile & 7, m0 = mt * 256, n0 = nt * 128;
    f32x16 ag[2][2], ap[2][2]; zero_acc(ag); zero_acc(ap);
    gemm_kloop<2, 2>(ag, 16,
      [&](int r, int ko, int kt) { return ldg16(hb + (size_t)(m0 + r) * DM + kt * 64 + ko); },
      [&](int r, int ko, int kt) { return ldg16(wpg + (size_t)(n0 + r) * DM + kt * 64 + ko); }, smem);
    gemm_kloop<2, 2>(ap, 4,
      [&](int r, int ko, int kt) { const float* s = pp + (size_t)(m0 + r) * 256 + kt * 64 + ko; return cvt8(*(const f32x4*)s, *(const f32x4*)(s + 4)); },
      [&](int r, int ko, int kt) { return ldg16(wpp + (size_t)(n0 + r) * 256 + kt * 64 + ko); }, smem);
#pragma unroll
    for (int tm = 0; tm < 2; ++tm)
#pragma unroll
      for (int tn = 0; tn < 2; ++tn)
#pragma unroll
        for (int i = 0; i < 16; ++i) ag[tm][tn][i] = sigmoidf_(ag[tm][tn][i]) * ap[tm][tn][i];
    gemm_epi_rows<2, 2>(ag, smem, [&](int m, int n, f32x4 v) {
      const size_t o = (size_t)(m0 + m) * DM + n0 + n;
      const f32x4 hv = *(const f32x4*)(P.out + o);
      float* dst = dry ? (float*)(P.ws + WS_R + 32 * MiB) : P.out;
      *(f32x4*)(dst + o) = hv + v;
    });
  }
}

#define XB_TMO      128
#define XB_XCNT(j)  (256  + 64 * (j))
#define XB_XSUB(j)  (1280 + 64 * (j))
#define XB_XGEN(j)  (2304 + 64 * (j))
#define XB_TOP      3328
#define XB_TOPGEN   3392
#define XCD_BAR_WORDS 3456
#define XB_SPIN_CAP (1u << 18)
#define LAS __attribute__((address_space(3)))

__device__ __forceinline__ unsigned xb_ld(unsigned* p)              { return __hip_atomic_load(p, __ATOMIC_RELAXED, __HIP_MEMORY_SCOPE_AGENT); }
__device__ __forceinline__ unsigned xb_add(unsigned* p, unsigned v) { return __hip_atomic_fetch_add(p, v, __ATOMIC_RELAXED, __HIP_MEMORY_SCOPE_AGENT); }
__device__ __forceinline__ unsigned xb_xcc_id() { return (unsigned)__builtin_amdgcn_s_getreg((3 << 11) | 20) & 0xFu; }
#define XB_SPIN(cond, bar) do { unsigned _sp = 0; while (cond) { __builtin_amdgcn_s_sleep(1); \
    if ((++_sp & 255u) == 0u) { if (xb_ld(&(bar)[XB_TMO])) break; if (_sp > XB_SPIN_CAP) { atomicAdd(&(bar)[XB_TMO], 1u); break; } } } } while (0)

struct XcdBarrier {
    unsigned* bar; unsigned x;
    volatile LAS unsigned* st;
};

__device__ __forceinline__ XcdBarrier xcd_barrier_post(unsigned* bar, volatile LAS unsigned* st) {
    XcdBarrier b; b.bar = bar; b.x = xb_xcc_id(); b.st = st;
    if (threadIdx.x == 0) (void)xb_add(&bar[XB_XCNT(b.x)], 1u);
    return b;
}
__device__ __forceinline__ void xcd_barrier_complete(unsigned* bar, unsigned x, unsigned& nloc, unsigned& nx) {
    const unsigned G = gridDim.x * gridDim.y * gridDim.z;
    unsigned sum, cnt, mine, sp = 0u;
    for (;;) {
        sum = 0u; cnt = 0u; mine = 0u;
#pragma unroll
        for (unsigned j = 0; j < 16; ++j) { const unsigned c = xb_ld(&bar[XB_XCNT(j)]); sum += c; cnt += (c > 0u) ? 1u : 0u; mine = (j == x) ? c : mine; }
        if (sum == G) break;
        __builtin_amdgcn_s_sleep(1);
        if ((++sp & 255u) == 0u) { if (xb_ld(&bar[XB_TMO])) break; if (sp > XB_SPIN_CAP) { atomicAdd(&bar[XB_TMO], 1u); break; } }
    }
    nloc = mine > 0u ? mine : 1u; nx = cnt > 0u ? cnt : 1u;
}

__device__ __forceinline__ void xcd_barrier(const XcdBarrier& b) {
    asm volatile("s_waitcnt vmcnt(0)" ::: "memory");
    __syncthreads();
    if (threadIdx.x == 0) {
        unsigned* bar = b.bar;
        __builtin_amdgcn_s_waitcnt(0);
        unsigned nloc = b.st[0], nx = b.st[1];
        if (nloc == 0u) { xcd_barrier_complete(bar, b.x, nloc, nx); b.st[0] = nloc; b.st[1] = nx; }
        const unsigned old = xb_add(&bar[XB_XSUB(b.x)], 1u);
        const unsigned gen = old / nloc;
        if (old + 1u == (gen + 1u) * nloc) {
            __builtin_amdgcn_fence(__ATOMIC_RELEASE, "agent");
            asm volatile("s_waitcnt vmcnt(0)" ::: "memory");
            const unsigned og = xb_add(&bar[XB_TOP], 1u);
            const unsigned tg = og / nx;
            if (og + 1u == (tg + 1u) * nx) xb_add(&bar[XB_TOPGEN], 1u);
            else XB_SPIN(xb_ld(&bar[XB_TOPGEN]) == tg, bar);
            __builtin_amdgcn_fence(__ATOMIC_ACQUIRE, "agent");
            xb_add(&bar[XB_XGEN(b.x)], 1u);
            asm volatile("s_waitcnt vmcnt(0)" ::: "memory");
        } else {
            XB_SPIN(xb_ld(&bar[XB_XGEN(b.x)]) == gen, bar);
            __builtin_amdgcn_fence(__ATOMIC_ACQUIRE, "agent");
            asm volatile("s_waitcnt vmcnt(0)" ::: "memory");
        }
    }
    __syncthreads();
}


DI void grid_barrier(unsigned* ctr, unsigned target) {
  asm volatile("s_waitcnt vmcnt(0)" ::: "memory");
  __syncthreads();
  if (threadIdx.x == 0) {
    __builtin_amdgcn_fence(__ATOMIC_RELEASE, "agent");
    asm volatile("s_waitcnt vmcnt(0)" ::: "memory");
    __hip_atomic_fetch_add(ctr, 1u, __ATOMIC_RELAXED, __HIP_MEMORY_SCOPE_AGENT);
    unsigned sp = 0;
    while (__hip_atomic_load(ctr, __ATOMIC_RELAXED, __HIP_MEMORY_SCOPE_AGENT) < target) {
      __builtin_amdgcn_s_sleep(1);
      if (++sp > (1u << 24)) break;
    }
    __builtin_amdgcn_fence(__ATOMIC_ACQUIRE, "agent");
    asm volatile("s_waitcnt vmcnt(0)" ::: "memory");
  }
  __syncthreads();
}

__global__ void __launch_bounds__(NTHR) mk_fwd(Params P) {
  extern __shared__ __attribute__((aligned(16))) unsigned char smem[];
  cg::grid_group grid = cg::this_grid();
  unsigned* bar_ctr = (unsigned*)(P.ws + SM_BAR);
  if (P.ph_lo > 1000) grid.sync();
  XcdBarrier xb;
  {
    volatile LAS unsigned* stw = (volatile LAS unsigned*)(smem + LDS_GEMM);
    if (threadIdx.x == 0) { stw[0] = 0u; stw[1] = 0u; stw[2] = 0u; stw[3] = 0u; }
    __syncthreads();
    if (P.ph_hi - P.ph_lo > 1) xb = xcd_barrier_post(bar_ctr, stw);
    else { xb.bar = bar_ctr; xb.x = 0; xb.st = stw; }
  }
  if ((PHASE_MASK & (1 << 0)) && P.ph_lo <= 0 && 0 < P.ph_hi) {
    if (P.ph_lo < 0) xcd_barrier(xb);
    for (int rep = 0; rep < (((REPEAT_MASK >> 0) & 1) ? 2 : 1); ++rep) phase_prep(P, smem);
    asm volatile("" ::: "memory");
  }
  if ((PHASE_MASK & (1 << 1)) && P.ph_lo <= 1 && 1 < P.ph_hi) {
    if (P.ph_lo < 1) xcd_barrier(xb);
    for (int rep = 0; rep < (((REPEAT_MASK >> 1) & 1) ? 2 : 1); ++rep) phase_inproj(P, smem);
    asm volatile("" ::: "memory");
  }
  if ((PHASE_MASK & (1 << 2)) && P.ph_lo <= 2 && 2 < P.ph_hi) {
    if (P.ph_lo < 2) xcd_barrier(xb);
    phase_queue(P, smem, bar_ctr + 8, (P.ph_hi - P.ph_lo) > 1);
    asm volatile("" ::: "memory");
  }
  if ((PHASE_MASK & (1 << 3)) && P.ph_lo <= 3 && 3 < P.ph_hi && (P.ph_hi - P.ph_lo) <= 1) {
    if (P.ph_lo < 3) xcd_barrier(xb);
    for (int rep = 0; rep < (((REPEAT_MASK >> 3) & 1) ? 2 : 1); ++rep) phase_cmp2(P, smem);
    asm volatile("" ::: "memory");
  }
  if ((PHASE_MASK & (1 << 4)) && P.ph_lo <= 4 && 4 < P.ph_hi) {
    if (P.ph_lo < 4 && (P.ph_hi - P.ph_lo) <= 1) xcd_barrier(xb);
    phase_nsa(P, smem, bar_ctr + 9, bar_ctr + 32, (P.ph_hi - P.ph_lo) > 1);
    asm volatile("" ::: "memory");
  }
  if ((PHASE_MASK & (1 << 5)) && P.ph_lo <= 5 && 5 < P.ph_hi) {
    if (P.ph_lo < 5) xcd_barrier(xb);
    for (int rep = 0; rep < (((REPEAT_MASK >> 5) & 1) ? 2 : 1); ++rep) phase_merge(P, smem);
    asm volatile("" ::: "memory");
  }
  if ((PHASE_MASK & (1 << 6)) && P.ph_lo <= 6 && 6 < P.ph_hi) {
    if (P.ph_lo < 6) xcd_barrier(xb);
    for (int rep = 0; rep < (((REPEAT_MASK >> 6) & 1) ? 2 : 1); ++rep) phase_outproj(P, smem);
    asm volatile("" ::: "memory");
  }
  if ((PHASE_MASK & (1 << 7)) && P.ph_lo <= 7 && 7 < P.ph_hi) {
    if (P.ph_lo < 7) xcd_barrier(xb);
    for (int rep = 0; rep < (((REPEAT_MASK >> 7) & 1) ? 2 : 1); ++rep) phase_ln1(P);
    asm volatile("" ::: "memory");
  }
  if ((PHASE_MASK & (1 << 8)) && P.ph_lo <= 8 && 8 < P.ph_hi) {
    if (P.ph_lo < 8) xcd_barrier(xb);
    for (int rep = 0; rep < (((REPEAT_MASK >> 8) & 1) ? 2 : 1); ++rep) phase_route(P, smem);
    asm volatile("" ::: "memory");
  }
  if ((PHASE_MASK & (1 << 9)) && P.ph_lo <= 9 && 9 < P.ph_hi) {
    if (P.ph_lo < 9) xcd_barrier(xb);
    for (int rep = 0; rep < (((REPEAT_MASK >> 9) & 1) ? 2 : 1); ++rep) phase_gather(P, smem);
    asm volatile("" ::: "memory");
  }
  if ((PHASE_MASK & (1 << 10)) && P.ph_lo <= 10 && 10 < P.ph_hi) {
    if (P.ph_lo < 10) xcd_barrier(xb);
    for (int rep = 0; rep < (((REPEAT_MASK >> 10) & 1) ? 2 : 1); ++rep) phase_final(P, smem, (((REPEAT_MASK >> 10) & 1) != 0) && rep == 0);
    for (int xs = 0; xs < EXTRA_SYNCS; ++xs) xcd_barrier(xb);
    asm volatile("" ::: "memory");
  }
}

static void add_job(Params& p, const float* src, size_t dst_off, int ld, int col0, int ncols, int npad, int K) {
  TJob& j = p.jobs[p.njobs++];
  j.src = src; j.dst = (bf16_t*)(p.ws + dst_off); j.ld = ld; j.col0 = col0; j.ncols = ncols; j.npad = npad; j.K = K; j.tile0 = p.ntiles_t;
  p.ntiles_t += (npad / 64) * (K / 64);
}

extern "C" void kernel_launch(void* const* d_in, const int* in_sizes, int n_in, void* d_out, int out_size, void* d_ws, size_t ws_size, hipStream_t stream) {
  static int grid = 0;
  if (grid == 0) {
    int dev = 0, cus = 0, per_cu = 0;
    hipGetDevice(&dev);
    hipDeviceGetAttribute(&cus, hipDeviceAttributeMultiprocessorCount, dev);
    hipFuncSetAttribute((const void*)mk_fwd, hipFuncAttributeMaxDynamicSharedMemorySize, LDS_BYTES);
    hipOccupancyMaxActiveBlocksPerMultiprocessor(&per_cu, (const void*)mk_fwd, NTHR, LDS_BYTES);
    if (per_cu < 1) { fprintf(stderr, "occupancy query returned %d\n", per_cu); per_cu = 1; }
    grid = cus * per_cu;
    (void)hipGetLastError();
  }
  Params p;
  memset(&p, 0, sizeof(p));
  for (int i = 0; i < 28; ++i) p.in[i] = (const float*)d_in[i];
  p.out = (float*)d_out; p.ws = (unsigned char*)d_ws;
  const float* w_in = p.in[2];
  const size_t e2 = 2;
  add_job(p, w_in, WS_WINR + e2 * 0 * 1024, 4888, 0, 512, 512, 1024);
  add_job(p, w_in, WS_WINR + e2 * 512 * 1024, 4888, 512, 128, 128, 1024);
  add_job(p, w_in, WS_WINR + e2 * 640 * 1024, 4888, 768, 128, 128, 1024);
  add_job(p, w_in, WS_WINR + e2 * 768 * 1024, 4888, 1024, 128, 128, 1024);
  add_job(p, w_in, WS_WINR + e2 * 896 * 1024, 4888, 640, 128, 128, 1024);
  add_job(p, w_in, WS_WINR + e2 * 1024 * 1024, 4888, 1304, 512, 512, 1024);
  add_job(p, w_in, WS_WINR + e2 * 1536 * 1024, 4888, 1816, 512, 512, 1024);
  add_job(p, w_in, WS_WINR + e2 * 2048 * 1024, 4888, 1280, 24, 128, 1024);
  add_job(p, w_in, WS_WINR + e2 * 2176 * 1024, 4888, 896, 128, 128, 1024);
  add_job(p, w_in, WS_WINR + e2 * 2304 * 1024, 4888, 1152, 128, 128, 1024);
  add_job(p, w_in, WS_WINR + e2 * 2432 * 1024, 4888, 2328, 512, 512, 1024);
  add_job(p, p.in[5], WS_CW1K, 256, 0, 256, 256, 2048);
  add_job(p, p.in[7], WS_CW1V, 256, 0, 256, 256, 2048);
  add_job(p, p.in[6], SM_CW2K, 64, 0, 64, 64, 256);
  add_job(p, p.in[8], SM_CW2V, 64, 0, 64, 64, 256);
  p.ntiles_early = p.ntiles_t;
  add_job(p, w_in, WS_WGATE, 4888, 2840, 2048, 2048, 1024);
  add_job(p, p.in[14], WS_WBN, 1024, 0, 1024, 1024, 512);
  add_job(p, p.in[15], WS_WBD, 1024, 0, 1024, 1024, 512);
  add_job(p, p.in[16], WS_WOUT, 1024, 0, 1024, 1024, 1024);
  add_job(p, p.in[19], WS_WQ, 2048, 0, 2048, 2048, 1024);
  add_job(p, p.in[27], WS_WPG, 1024, 0, 1024, 1024, 1024);
  add_job(p, p.in[26], WS_WPP, 1024, 0, 1024, 1024, 256);
#if MULTI_LAUNCH
  for (int ph = 0; ph < NPHASE; ++ph) {
    p.ph_lo = ph; p.ph_hi = ph + 1;
    hipLaunchKernelGGL(mk_fwd, dim3(grid), dim3(NTHR), LDS_BYTES, stream, p);
  }
#else
  p.ph_lo = 0; p.ph_hi = NPHASE;
  (void)hipMemsetAsync((char*)d_ws + SM_BAR, 0, XCD_BAR_WORDS * 4, stream);
  void* args[] = {&p};
  hipError_t e = hipLaunchCooperativeKernel((const void*)mk_fwd, dim3(grid), dim3(NTHR), args, LDS_BYTES, stream);
  if (e != hipSuccess) fprintf(stderr, "cooperative launch failed: %s (grid %d)\n", hipGetErrorString(e), grid);
#endif
}
```

```cpp
#include <hip/hip_runtime.h>
#include <hip/hip_cooperative_groups.h>
#include <cstdio>
#include <cstring>
namespace cg = cooperative_groups;

#ifndef PHASE_MASK
#define PHASE_MASK 0x7ff
#endif
#ifndef REPEAT_MASK
#define REPEAT_MASK 0
#endif
#ifndef PROBE_SEL
#define PROBE_SEL 3
#endif
#ifndef EXTRA_SYNCS
#define EXTRA_SYNCS 0
#endif
#ifndef MULTI_LAUNCH
#define MULTI_LAUNCH 0
#endif

#define DI __device__ __forceinline__
typedef short bf16x8 __attribute__((ext_vector_type(8)));
typedef short s16x4 __attribute__((ext_vector_type(4)));
typedef float f32x16 __attribute__((ext_vector_type(16)));
typedef float f32x4 __attribute__((ext_vector_type(4)));
typedef float f32x2 __attribute__((ext_vector_type(2)));
typedef unsigned u32x4 __attribute__((ext_vector_type(4)));
typedef unsigned u32x2 __attribute__((ext_vector_type(2)));
typedef __bf16 bf2_t __attribute__((ext_vector_type(2)));
typedef unsigned short bf16_t;

#define MFMA(a, b, c) __builtin_amdgcn_mfma_f32_32x32x16_bf16((a), (b), (c), 0, 0, 0)

constexpr int T = 16384, SEQ = 2048, DM = 1024;
constexpr int NTHR = 512;
constexpr int PJ = 2176;
constexpr int NPHASE = 11;
constexpr size_t MiB = 1u << 20;
constexpr size_t WS_WINR = 0, WS_WGATE = 6 * MiB, WS_WBN = 10 * MiB, WS_WBD = 11 * MiB, WS_WOUT = 12 * MiB, WS_WQ = 14 * MiB,
                 WS_WPG = 18 * MiB, WS_WPP = 20 * MiB, WS_CW1K = 21 * MiB, WS_CW1V = 22 * MiB, WS_SMALL = 23 * MiB,
                 WS_XB = 24 * MiB, WS_R = 56 * MiB;
constexpr size_t SM_CW2K = WS_SMALL, SM_CW2V = WS_SMALL + 32768, SM_SK1 = WS_SMALL + 65536, SM_SK2 = WS_SMALL + 98304,
                 SM_CBIAS = WS_SMALL + 131072  , SM_LAM = SM_CBIAS + 32768, SM_BAR = SM_LAM + 1024;
constexpr size_t R_PROJ = WS_R, R_VT = WS_R + 68 * MiB, R_HID = WS_R + 92 * MiB, R_KC = WS_R + 94 * MiB, R_VCT = R_KC + 262144,
                 R_ONSA = WS_R + 95 * MiB, R_ODIFF = WS_R + 111 * MiB;
constexpr size_t R_MERGED = WS_R, R_UB = WS_R + 32 * MiB, R_VB = WS_R + 64 * MiB, R_EID = WS_R + 96 * MiB, R_GW = WS_R + 104 * MiB;
constexpr size_t R_UB8 = 184 * MiB, R_VB8 = 200 * MiB, R_USC = 216 * MiB, R_VSC = R_USC + 65536;
constexpr size_t WS_H1 = 184 * MiB;
constexpr int LDS_GEMM = 147456;
constexpr int LDS_BYTES = LDS_GEMM + 64;
constexpr float LN_ALPHA = 1.189207115f;
constexpr float NEGBIG = -1.0e30f;
constexpr float MINIT = -1.0e9f;

struct TJob { const float* src; bf16_t* dst; int ld, col0, ncols, npad, K, tile0; };
constexpr int MAXJOBS = 24;
struct Params {
  const float* in[28];
  float* out;
  unsigned char* ws;
  TJob jobs[MAXJOBS];
  int njobs, ntiles_t, ntiles_early, pad0, ph_lo, ph_hi;
};

DI unsigned pack2(float a, float b) { f32x2 v = {a, b}; return __builtin_bit_cast(unsigned, __builtin_convertvector(v, bf2_t)); }
DI bf16_t f2bf(float a) { return (bf16_t)(pack2(a, 0.f) & 0xffffu); }
DI float sigmoidf_(float x) { return __builtin_amdgcn_rcpf(1.f + __builtin_amdgcn_exp2f(-1.44269504f * x)); }
DI float geluf_(float x) { return 0.5f * x * (1.f + erff(x * 0.70710678118f)); }
DI float bflo(unsigned w) { return __uint_as_float(w << 16); }
DI float bfhi(unsigned w) { return __uint_as_float(w & 0xffff0000u); }
DI int crow_(int i, int h) { return (i & 3) + 8 * (i >> 2) + 4 * h; }
DI u32x4 cvt8(f32x4 a, f32x4 b) { u32x4 r; r[0] = pack2(a[0], a[1]); r[1] = pack2(a[2], a[3]); r[2] = pack2(b[0], b[1]); r[3] = pack2(b[2], b[3]); return r; }
DI f32x16 zero16() { f32x16 z; for (int i = 0; i < 16; ++i) z[i] = 0.f; return z; }


namespace pg8 {
#define PG8_LAS __attribute__((address_space(3)))
typedef unsigned short bf16_t;
typedef short bf16x8 __attribute__((ext_vector_type(8)));
typedef float f32x4 __attribute__((ext_vector_type(4)));
typedef unsigned u32x4 __attribute__((ext_vector_type(4)));
constexpr int BM = 256, BK = 64, HALF = 128, HTB = HALF * BK * 2  , STAGE_BYTES = 8 * HTB, NXCD = 8, WGM = 8;

__host__ __device__ __forceinline__ int lds_byte(int r, int c) { const int st = (r >> 4) * 2 + (c >> 5), rr = r & 15, cc = c & 31, ob = rr * 64 + cc * 2; return st * 1024 + (ob ^ (((ob >> 9) & 1) << 5)); }
__host__ __device__ __forceinline__ void stage_rc(int b, int& R, int& C) { const int st = b / 1024, sb = b % 1024, swz = sb ^ (((sb >> 9) & 1) << 5); R = (st >> 1) * 16 + swz / 64; C = (st & 1) * 32 + (swz % 64) / 2; }
__host__ __device__ __forceinline__ int perm32(int rho) { const int n = rho >> 4, i = rho & 15; return 8 * (i >> 2) + 4 * n + (i & 3); }

struct Unit { int pm, pn; };
struct Gemm { const bf16_t* A; const bf16_t* Bt; int M, N, K; };

struct StaticOrder {
    int nM, nN, nwg, G, c;
    __host__ __device__ void init(int M, int N, int G_, int c_) { nM = M / BM; nN = N / BM; nwg = nM * nN; G = G_; c = c_; }
    __host__ __device__ bool next(int i, Unit& u) const {
        const long L = (long)i * G + c; if (L >= nwg) return false;
        int wgid = (int)L; { const int q = nwg / NXCD, r = nwg % NXCD, xcd = wgid % NXCD, off = wgid / NXCD; wgid = (xcd < r ? xcd * (q + 1) : r * (q + 1) + (xcd - r) * q) + off; }
        const int nig = WGM * nN, gid = wgid / nig, fm = gid * WGM, gsz = (nM - fm) < WGM ? (nM - fm) : WGM;
        u.pm = fm + ((wgid % nig) % gsz); u.pn = (wgid % nig) / gsz; return true;
    }
    __device__ __forceinline__ void a_ready(const Unit&) const {}
    __device__ __forceinline__ void done(const Unit&) const {}
};
struct CountedOrder : StaticOrder {
    const unsigned* ready; unsigned need; unsigned* tmo;
    __device__ __forceinline__ void a_ready(const Unit& u) const {
        if (threadIdx.x < 64) {
            const unsigned long long t0 = __builtin_amdgcn_s_memrealtime(); unsigned polls = 0;
            while ((unsigned)__builtin_amdgcn_readfirstlane(__hip_atomic_load(ready + 64 * u.pm, __ATOMIC_RELAXED, __HIP_MEMORY_SCOPE_AGENT)) < need) {
                if ((++polls & 255u) == 0u && __builtin_amdgcn_readfirstlane(__hip_atomic_load(tmo, __ATOMIC_RELAXED, __HIP_MEMORY_SCOPE_AGENT)) != 0u) break;
                if (__builtin_amdgcn_s_memrealtime() - t0 > 2000000ull) {
                    if (threadIdx.x == 0) { unsigned expect = 0u; __hip_atomic_compare_exchange_strong(tmo + 1, &expect, 0x600u | (unsigned)(u.pm & 0xff), __ATOMIC_RELAXED, __ATOMIC_RELAXED, __HIP_MEMORY_SCOPE_AGENT); __hip_atomic_store(tmo, 1u, __ATOMIC_RELAXED, __HIP_MEMORY_SCOPE_AGENT); }
                    break; }
                __builtin_amdgcn_s_sleep(2); }
            __builtin_amdgcn_fence(__ATOMIC_ACQUIRE, "agent");
            asm volatile("s_waitcnt vmcnt(0)" ::: "memory");
        }
#if !defined(BROKEN_HOOK_NO_BARRIER)
        asm volatile("" ::: "memory"); __builtin_amdgcn_s_barrier(); asm volatile("" ::: "memory");
#endif
    }
};

__device__ __forceinline__ unsigned cvt_pk_bf16(float lo, float hi) { unsigned r; asm volatile("v_cvt_pk_bf16_f32 %0, %1, %2" : "=v"(r) : "v"(lo), "v"(hi)); return r; }
typedef float f32x2 __attribute__((ext_vector_type(2)));
__device__ __forceinline__ f32x2 gelu_pk(f32x2 v) {
    const f32x2 av = __builtin_elementwise_abs(v), d = av * 0.2316418882f + 1.0f;
    f32x2 t; t.x = __builtin_amdgcn_rcpf(d.x); t.y = __builtin_amdgcn_rcpf(d.y);
    f32x2 q = t * 0.5307027145f + (-0.7265760135f); q = q * t + 0.7107068705f; q = q * t + (-0.142248368f); q = q * t + 0.127414796f; q = q * t;
    const f32x2 s = (v * v) * (-0.72134752044f);
    f32x2 e; e.x = __builtin_amdgcn_exp2f(s.x); e.y = __builtin_amdgcn_exp2f(s.y);
    const f32x2 m = v * (q * e), r = v - m;
    f32x2 o; o.x = v.x < 0.f ? m.x : r.x; o.y = v.y < 0.f ? m.y : r.y; return o;
}

struct EpiF32 {
    static constexpr bool PERM = false, AFTER_DRAIN = false;
    float* C; int ldc; const float* bias;
    __device__ __forceinline__ void operator()(const f32x4 (&acc)[2][2][4][2], const Unit& u, int wr, int wc, int fr, int fq) const {
        const int row0 = u.pm * BM + wr * 64 + fr, col0 = u.pn * BM + wc * 32 + 4 * fq;
        f32x4 bv[2][2];
#pragma unroll
        for (int bj = 0; bj < 2; ++bj)
#pragma unroll
            for (int n = 0; n < 2; ++n) bv[bj][n] = bias ? *(const f32x4*)(bias + col0 + bj * HALF + n * 16) : (f32x4){0.f, 0.f, 0.f, 0.f};
#pragma unroll
        for (int ai = 0; ai < 2; ++ai)
#pragma unroll
            for (int m = 0; m < 4; ++m) { float* rowp = C + (size_t)(row0 + ai * HALF + m * 16) * ldc + col0;
#pragma unroll
                for (int bj = 0; bj < 2; ++bj)
#pragma unroll
                    for (int n = 0; n < 2; ++n) *(f32x4*)(rowp + bj * HALF + n * 16) = acc[ai][bj][m][n] + bv[bj][n]; }
    }
};
template <int ACT  > struct EpiBf16 {
    static constexpr bool PERM = true, AFTER_DRAIN = false;
    bf16_t* O; int ldc; const float* bias; int split_cols; size_t split_stride;
    __device__ __forceinline__ void operator()(const f32x4 (&acc)[2][2][4][2], const Unit& u, int wr, int wc, int fr, int fq) const {
        const int row0 = u.pm * BM + wr * 64 + fr; int colt = u.pn * BM; bf16_t* base = O;
        if (split_cols) { const int t = colt / split_cols; base += (size_t)t * split_stride; colt -= t * split_cols; }
        const int col0 = colt + wc * 32 + 8 * fq, bcol0 = u.pn * BM + wc * 32 + 8 * fq;
        f32x4 bv[2][2];
#pragma unroll
        for (int bj = 0; bj < 2; ++bj)
#pragma unroll
            for (int n = 0; n < 2; ++n) bv[bj][n] = bias ? *(const f32x4*)(bias + bcol0 + bj * HALF + 4 * n) : (f32x4){0.f, 0.f, 0.f, 0.f};
#pragma unroll
        for (int ai = 0; ai < 2; ++ai)
#pragma unroll
            for (int m = 0; m < 4; ++m) { bf16_t* rowp = base + (size_t)(row0 + ai * HALF + m * 16) * ldc + col0;
#pragma unroll
                for (int bj = 0; bj < 2; ++bj) { f32x4 v0 = acc[ai][bj][m][0] + bv[bj][0], v1 = acc[ai][bj][m][1] + bv[bj][1];
                    if (ACT == 1) { f32x2 a = gelu_pk((f32x2){v0[0], v0[1]}), b = gelu_pk((f32x2){v0[2], v0[3]}), c = gelu_pk((f32x2){v1[0], v1[1]}), d = gelu_pk((f32x2){v1[2], v1[3]});
                        v0 = (f32x4){a.x, a.y, b.x, b.y}; v1 = (f32x4){c.x, c.y, d.x, d.y}; }
                    if (ACT == 2) {
#pragma unroll
                        for (int j = 0; j < 4; ++j) { v0[j] = 0.5f * v0[j] * (1.0f + erff(v0[j] * 0.70710678f)); v1[j] = 0.5f * v1[j] * (1.0f + erff(v1[j] * 0.70710678f)); } }
                    u32x4 w; w.x = cvt_pk_bf16(v0[0], v0[1]); w.y = cvt_pk_bf16(v0[2], v0[3]); w.z = cvt_pk_bf16(v1[0], v1[1]); w.w = cvt_pk_bf16(v1[2], v1[3]);
                    *(u32x4*)(rowp + bj * HALF) = w; } }
    }
};

struct PanelStats {
    unsigned* xbuf;
    unsigned* cnt;
    unsigned* tmo;
    int ntn; float eps;
    unsigned code;
    __device__ __forceinline__ bool run(const f32x4 (&v)[2][2][4][2], const Unit& u, int wr, int wc, int fr, int fq, PG8_LAS unsigned char* lds, int wid, int lane) const {
        typedef float f32x2v __attribute__((ext_vector_type(2)));
        PG8_LAS f32x2v* P = (PG8_LAS f32x2v*)lds;
        PG8_LAS f32x2v* S = (PG8_LAS f32x2v*)(lds + 8192);
        PG8_LAS unsigned* flag = (PG8_LAS unsigned*)(lds + 8192 + 2048);
#pragma unroll
        for (int ai = 0; ai < 2; ++ai)
#pragma unroll
            for (int m = 0; m < 4; ++m) {
                float s = 0.f;
#pragma unroll
                for (int bj = 0; bj < 2; ++bj)
#pragma unroll
                    for (int n = 0; n < 2; ++n) { const f32x4 x = v[ai][bj][m][n]; s += (x[0] + x[1]) + (x[2] + x[3]); }
                s += __shfl_xor(s, 16); s += __shfl_xor(s, 32);
                const float mw = s * (1.0f / 64.0f); float q = 0.f;
#pragma unroll
                for (int bj = 0; bj < 2; ++bj)
#pragma unroll
                    for (int n = 0; n < 2; ++n) { const f32x4 d = v[ai][bj][m][n] - mw; q += (d[0] * d[0] + d[1] * d[1]) + (d[2] * d[2] + d[3] * d[3]); }
                q += __shfl_xor(q, 16); q += __shfl_xor(q, 32);
                if (fq == 0) P[(ai * HALF + wr * 64 + m * 16 + fr) * 4 + wc] = (f32x2v){mw, q};
            }
        asm volatile("s_waitcnt lgkmcnt(0)" ::: "memory"); __builtin_amdgcn_s_barrier(); asm volatile("" ::: "memory");
#if defined(BROKEN_NO_WAIT)
        if (blockIdx.x >= 64) { const long long t0 = clock64(); while (clock64() - t0 < 60000) __builtin_amdgcn_s_sleep(8); }
#endif
        const int row = wid * 32 + (lane & 31);
        if (lane < 32) {
            const f32x2v a = P[row * 4 + 0], b = P[row * 4 + 1], c = P[row * 4 + 2], d = P[row * 4 + 3];
            const float mt = (a.x + b.x + c.x + d.x) * 0.25f;
            const float da = a.x - mt, db = b.x - mt, dc = c.x - mt, dd = d.x - mt;
            const float m2 = (a.y + b.y) + (c.y + d.y) + 64.0f * ((da * da + db * db) + (dc * dc + dd * dd));
            unsigned long long* slot = (unsigned long long*)xbuf + ((size_t)(u.pm * BM + row) * 4 + u.pn);
            __hip_atomic_store(slot, ((unsigned long long)__float_as_uint(m2) << 32) | __float_as_uint(mt), __ATOMIC_RELAXED, __HIP_MEMORY_SCOPE_AGENT);
        }
        asm volatile("s_waitcnt vmcnt(0)" ::: "memory");
        if (lane == 0) __hip_atomic_fetch_add(cnt + 64 * u.pm, 1u, __ATOMIC_RELAXED, __HIP_MEMORY_SCOPE_AGENT);
        if (wid == 0) {
            bool dead = false; const unsigned long long t0 = __builtin_amdgcn_s_memrealtime(); const unsigned want = 8u * (unsigned)ntn;
            for (;;) {
#if defined(BROKEN_NO_WAIT)
                break;
#endif
                if ((unsigned)__builtin_amdgcn_readfirstlane(__hip_atomic_load(cnt + 64 * u.pm, __ATOMIC_RELAXED, __HIP_MEMORY_SCOPE_AGENT)) >= want) break;
                if (__builtin_amdgcn_s_memrealtime() - t0 > 2000000ull) {
                    if (lane == 0) { unsigned expect = 0u; __hip_atomic_compare_exchange_strong(tmo + 1, &expect, code | (unsigned)(u.pm & 0xff), __ATOMIC_RELAXED, __ATOMIC_RELAXED, __HIP_MEMORY_SCOPE_AGENT);
                                     __hip_atomic_store(tmo, 1u, __ATOMIC_RELAXED, __HIP_MEMORY_SCOPE_AGENT); }
                    dead = true; break; }
                __builtin_amdgcn_s_sleep(2);
            }
            __builtin_amdgcn_fence(__ATOMIC_ACQUIRE, "agent");
            if (lane == 0) flag[0] = dead ? 1u : 0u;
        }
        asm volatile("s_waitcnt vmcnt(0) lgkmcnt(0)" ::: "memory"); __builtin_amdgcn_s_barrier(); asm volatile("" ::: "memory");
        const bool bad = flag[0] != 0u;
        if (lane < 32) {
            const unsigned long long* slot = (const unsigned long long*)xbuf + (size_t)(u.pm * BM + row) * 4; float mt[4], m2[4]; float ms = 0.f;
#pragma unroll
            for (int t = 0; t < 4; ++t) { if (t < ntn) { const unsigned long long w = __hip_atomic_load(slot + t, __ATOMIC_RELAXED, __HIP_MEMORY_SCOPE_AGENT); mt[t] = __uint_as_float((unsigned)w); m2[t] = __uint_as_float((unsigned)(w >> 32)); } else { mt[t] = 0.f; m2[t] = 0.f; } ms += mt[t]; }
            const float mean = ms / (float)ntn; float q = 0.f;
#pragma unroll
            for (int t = 0; t < 4; ++t) if (t < ntn) { const float dm = mt[t] - mean; q += m2[t] + 256.0f * dm * dm; }
            S[row] = (f32x2v){mean, 1.0f / sqrtf(q / (256.0f * (float)ntn) + eps)};
        }
        asm volatile("s_waitcnt lgkmcnt(0)" ::: "memory"); __builtin_amdgcn_s_barrier(); asm volatile("" ::: "memory");
        return bad;
    }
};
struct EpiLnRes {
    static constexpr bool PERM = false, AFTER_DRAIN = true;
    const float* base; float* out; int ldc; const float* bias; PanelStats st; unsigned poison;
    __device__ __forceinline__ void refuse(size_t i0, size_t stride, int M, int N) const { const float q = __builtin_nanf(""); for (size_t i = i0; i < (size_t)M * N; i += stride) out[(i / N) * ldc + i % N] = q;
        if (i0 == 0) { unsigned expect = 0u; __hip_atomic_compare_exchange_strong(st.tmo + 1, &expect, 0x7f0u, __ATOMIC_RELAXED, __ATOMIC_RELAXED, __HIP_MEMORY_SCOPE_AGENT); __hip_atomic_store(st.tmo, 1u, __ATOMIC_RELAXED, __HIP_MEMORY_SCOPE_AGENT); } }
    __device__ __forceinline__ void fused(f32x4 (&acc)[2][2][4][2], const Unit& u, int wr, int wc, int fr, int fq, PG8_LAS unsigned char* lds, int wid, int lane) const {
        typedef float f32x2v __attribute__((ext_vector_type(2)));
        const PG8_LAS f32x2v* S = (const PG8_LAS f32x2v*)(lds + 8192);
        const int col0 = u.pn * BM + wc * 32 + 4 * fq;
#pragma unroll
        for (int bj = 0; bj < 2; ++bj)
#pragma unroll
            for (int n = 0; n < 2; ++n) { const f32x4 bv = bias ? *(const f32x4*)(bias + col0 + bj * HALF + n * 16) : (f32x4){0.f, 0.f, 0.f, 0.f};
#pragma unroll
                for (int ai = 0; ai < 2; ++ai)
#pragma unroll
                    for (int m = 0; m < 4; ++m) acc[ai][bj][m][n] += bv; }
        const bool bad = st.run(acc, u, wr, wc, fr, fq, lds, wid, lane) || poison != 0u;
        const float qnan = __builtin_nanf("");
#pragma unroll
        for (int ai = 0; ai < 2; ++ai)
#pragma unroll
            for (int m = 0; m < 4; ++m) { const int r = ai * HALF + wr * 64 + m * 16 + fr; const f32x2v sr = S[r]; const size_t off = (size_t)(u.pm * BM + r) * ldc + col0;
#pragma unroll
                for (int bj = 0; bj < 2; ++bj)
#pragma unroll
                    for (int n = 0; n < 2; ++n) { const f32x4 bs = *(const f32x4*)(base + off + bj * HALF + n * 16); f32x4 o = bs + (acc[ai][bj][m][n] - sr.x) * sr.y;
                        if (bad) o = (f32x4){qnan, qnan, qnan, qnan}; *(f32x4*)(out + off + bj * HALF + n * 16) = o; }
                asm volatile("" ::: "memory"); }
    }
};
struct EpiLnResLn {
    static constexpr bool PERM = false, AFTER_DRAIN = true;
    const float* base; float* out; bf16_t* xn; int ldc; const float* bias; PanelStats st1, st2; unsigned poison;
    __device__ __forceinline__ void refuse(size_t i0, size_t stride, int M, int N) const { const float q = __builtin_nanf(""); for (size_t i = i0; i < (size_t)M * N; i += stride) { const size_t o = (i / N) * ldc + i % N; out[o] = q; xn[o] = (bf16_t)0x7fc0u; }
        if (i0 == 0) { unsigned expect = 0u; __hip_atomic_compare_exchange_strong(st1.tmo + 1, &expect, 0x7f0u, __ATOMIC_RELAXED, __ATOMIC_RELAXED, __HIP_MEMORY_SCOPE_AGENT); __hip_atomic_store(st1.tmo, 1u, __ATOMIC_RELAXED, __HIP_MEMORY_SCOPE_AGENT); } }
    __device__ __forceinline__ void fused(f32x4 (&acc)[2][2][4][2], const Unit& u, int wr, int wc, int fr, int fq, PG8_LAS unsigned char* lds, int wid, int lane) const {
        typedef float f32x2v __attribute__((ext_vector_type(2))); typedef unsigned u32x2v __attribute__((ext_vector_type(2)));
        const PG8_LAS f32x2v* S = (const PG8_LAS f32x2v*)(lds + 8192);
        const int col0 = u.pn * BM + wc * 32 + 4 * fq;
#pragma unroll
        for (int bj = 0; bj < 2; ++bj)
#pragma unroll
            for (int n = 0; n < 2; ++n) { const f32x4 bv = bias ? *(const f32x4*)(bias + col0 + bj * HALF + n * 16) : (f32x4){0.f, 0.f, 0.f, 0.f};
#pragma unroll
                for (int ai = 0; ai < 2; ++ai)
#pragma unroll
                    for (int m = 0; m < 4; ++m) acc[ai][bj][m][n] += bv; }
        bool bad = st1.run(acc, u, wr, wc, fr, fq, lds, wid, lane) || poison != 0u;
        const float qnan = __builtin_nanf("");
#pragma unroll
        for (int ai = 0; ai < 2; ++ai)
#pragma unroll
            for (int m = 0; m < 4; ++m) { const int r = ai * HALF + wr * 64 + m * 16 + fr; const f32x2v sr = S[r]; const size_t off = (size_t)(u.pm * BM + r) * ldc + col0;
#pragma unroll
                for (int bj = 0; bj < 2; ++bj)
#pragma unroll
                    for (int n = 0; n < 2; ++n) { const f32x4 bs = *(const f32x4*)(base + off + bj * HALF + n * 16); acc[ai][bj][m][n] = bs + (acc[ai][bj][m][n] - sr.x) * sr.y; }
                asm volatile("" : "+v"(acc[ai][0][m][0]), "+v"(acc[ai][0][m][1]), "+v"(acc[ai][1][m][0]), "+v"(acc[ai][1][m][1]));
                if (m & 1) asm volatile("" ::: "memory"); }
        const bool bad1 = bad;
        bad = st2.run(acc, u, wr, wc, fr, fq, lds, wid, lane) || bad;
#pragma unroll
        for (int ai = 0; ai < 2; ++ai)
#pragma unroll
            for (int m = 0; m < 4; ++m) { const int r = ai * HALF + wr * 64 + m * 16 + fr; const f32x2v sr = S[r]; const size_t off = (size_t)(u.pm * BM + r) * ldc + col0;
#pragma unroll
                for (int bj = 0; bj < 2; ++bj)
#pragma unroll
                    for (int n = 0; n < 2; ++n) { const f32x4 x1 = acc[ai][bj][m][n]; *(f32x4*)(out + off + bj * HALF + n * 16) = bad1 ? (f32x4){qnan, qnan, qnan, qnan} : x1;
                        const f32x4 o = (x1 - sr.x) * sr.y; u32x2v w; w.x = cvt_pk_bf16(o[0], o[1]); w.y = cvt_pk_bf16(o[2], o[3]);
                        if (bad) { w.x = 0x7fc07fc0u; w.y = 0x7fc07fc0u; } *(u32x2v*)(xn + off + bj * HALF + n * 16) = w; }
                asm volatile("" ::: "memory"); }
    }
};

template <class Epi, class Sched, bool STAMP = false>
__device__ __forceinline__ void gemm_phase(PG8_LAS unsigned char* lds, const Gemm g, const Sched& S, const Epi& E, unsigned long long* stamps) {
    const int tid = threadIdx.x, wid = __builtin_amdgcn_readfirstlane(tid >> 6), lane = tid & 63, wr = wid >> 2, wc = wid & 3, fr = lane & 15, fq = lane >> 4;
    const int K = g.K, nt = K / BK;
    int ts_lo = 0, ts_hi = 0, nts = 0; const unsigned long long rt_entry = STAMP ? (unsigned long long)wall_clock64() : 0ull;
#define PG8_STAMP() do { if (STAMP && wid == 0 && nts < 64) { const unsigned long long _c = (unsigned long long)clock64(); \
        ts_lo = (lane == nts) ? (int)(unsigned)_c : ts_lo; ts_hi = (lane == nts) ? (int)(unsigned)(_c >> 32) : ts_hi; ++nts; } } while (0)
    PG8_STAMP();
    unsigned voffA[2], voffB[2];
#pragma unroll
    for (int i = 0; i < 2; ++i) { int R, C; stage_rc(tid * 16 + i * 8192, R, C); const int Rb = Epi::PERM ? ((R & ~31) + perm32(R & 31)) : R;
        voffA[i] = (unsigned)(R * K + C) * 2u; voffB[i] = (unsigned)(Rb * K + C) * 2u; }
    const size_t kstep = (size_t)(BK * 2);
    const size_t hstep = (size_t)HALF * K * 2;
    const size_t tstep = 2 * hstep;
    const unsigned ldsw = (unsigned)wid * 1024u;
    const int aoff = lds_byte(wr * 64 + fr, fq * 8), boff = lds_byte(wc * 32 + fr, fq * 8);
#define PG8_SA(b, h) (((b) * 2 + (h)) * HTB)
#define PG8_SB(b, h) ((4 + (b) * 2 + (h)) * HTB)
#define PG8_STAGE(bufoff, gbase, voff) do { _Pragma("unroll") for (int _i = 0; _i < 2; ++_i) \
        __builtin_amdgcn_global_load_lds((const unsigned*)((const char*)(gbase) + (voff)[_i]), (PG8_LAS unsigned*)(lds + (bufoff) + ldsw + _i * 8192), 16, 0, 0); } while (0)
#define PG8_LDA(dst, b, h) do { _Pragma("unroll") for (int m = 0; m < 4; ++m) _Pragma("unroll") for (int k = 0; k < 2; ++k) dst[m][k] = *(const PG8_LAS bf16x8*)(lds + PG8_SA(b, h) + aoff + m * 2048 + k * 1024); } while (0)
#define PG8_LDB(dst, b, h) do { _Pragma("unroll") for (int n = 0; n < 2; ++n) _Pragma("unroll") for (int k = 0; k < 2; ++k) dst[n][k] = *(const PG8_LAS bf16x8*)(lds + PG8_SB(b, h) + boff + n * 2048 + k * 1024); } while (0)
#define PG8_MMA(ai, bj, At, Bt) do { __builtin_amdgcn_s_setprio(1); _Pragma("unroll") for (int m = 0; m < 4; ++m) _Pragma("unroll") for (int n = 0; n < 2; ++n) _Pragma("unroll") for (int k = 0; k < 2; ++k) \
        acc[ai][bj][m][n] = __builtin_amdgcn_mfma_f32_16x16x32_bf16(Bt[n][k], At[m][k], acc[ai][bj][m][n], 0, 0, 0); __builtin_amdgcn_s_setprio(0); } while (0)
#define PG8_WAIT_V(n) asm volatile("s_waitcnt vmcnt(" #n ")" ::: "memory")
#define PG8_WAIT_L(n) asm volatile("s_waitcnt lgkmcnt(" #n ")" ::: "memory")
#define PG8_BAR __builtin_amdgcn_s_barrier()
#define PG8_SCHED __builtin_amdgcn_sched_barrier(0)
    Unit cur, nxt; int ui = 0;
    if (!S.next(0, cur)) return;
    f32x4 acc[2][2][4][2];
#pragma unroll
    for (int a = 0; a < 2; ++a)
#pragma unroll
        for (int b = 0; b < 2; ++b)
#pragma unroll
            for (int m = 0; m < 4; ++m)
#pragma unroll
                for (int n = 0; n < 2; ++n) acc[a][b][m][n] = (f32x4){0.f, 0.f, 0.f, 0.f};
    bf16x8 At[4][2], B0[2][2], B1[2][2];
    const char* cA = (const char*)g.A + (size_t)cur.pm * tstep; const char* cB = (const char*)g.Bt + (size_t)cur.pn * tstep;
    S.a_ready(cur);
    PG8_STAGE(PG8_SB(0, 0), cB, voffB); PG8_STAGE(PG8_SA(0, 0), cA, voffA); PG8_STAGE(PG8_SB(0, 1), cB + hstep, voffB); PG8_STAGE(PG8_SA(0, 1), cA + hstep, voffA);
    if (wr == 1) PG8_BAR;
    PG8_WAIT_V(4); PG8_BAR;
    PG8_STAGE(PG8_SB(1, 0), cB + kstep, voffB); PG8_STAGE(PG8_SA(1, 0), cA + kstep, voffA); PG8_STAGE(PG8_SB(1, 1), cB + hstep + kstep, voffB);
    PG8_WAIT_V(6); PG8_BAR;
    PG8_STAMP();
    for (;;) {
        const bool has_next = S.next(ui + 1, nxt);
        const char* nA = has_next ? (const char*)g.A + (size_t)nxt.pm * tstep : cA; const char* nB = has_next ? (const char*)g.Bt + (size_t)nxt.pn * tstep : cB;
        for (int t = 0; t < nt; t += 2) {
            const bool last = (t == nt - 2);
            const char* a1 = cA + (size_t)(t + 1) * kstep;
            const char* a2 = last ? nA : cA + (size_t)(t + 2) * kstep; const char* b2 = last ? nB : cB + (size_t)(t + 2) * kstep;
            const char* a3 = a2 + kstep; const char* b3 = b2 + kstep;
            if (last && has_next) S.a_ready(nxt);
            PG8_LDB(B0, 0, 0); PG8_SCHED; PG8_LDA(At, 0, 0); PG8_STAGE(PG8_SA(1, 1), a1 + hstep, voffA);
            PG8_WAIT_L(8); PG8_BAR; PG8_WAIT_L(0); PG8_MMA(0, 0, At, B0); PG8_BAR; PG8_SCHED;
            PG8_LDB(B1, 0, 1); PG8_STAGE(PG8_SB(0, 0), b2, voffB);
            PG8_BAR; PG8_WAIT_L(0); PG8_MMA(0, 1, At, B1); PG8_BAR;
            PG8_LDA(At, 0, 1); PG8_STAGE(PG8_SA(0, 0), a2, voffA);
            PG8_BAR; PG8_WAIT_L(0); PG8_MMA(1, 0, At, B0); PG8_BAR; PG8_SCHED;
            PG8_STAGE(PG8_SB(0, 1), b2 + hstep, voffB);
            PG8_WAIT_V(6); PG8_BAR; PG8_MMA(1, 1, At, B1); PG8_BAR;
            PG8_LDB(B0, 1, 0); PG8_SCHED; PG8_LDA(At, 1, 0); PG8_STAGE(PG8_SA(0, 1), a2 + hstep, voffA);
            PG8_WAIT_L(8); PG8_BAR; PG8_WAIT_L(0); PG8_MMA(0, 0, At, B0); PG8_BAR; PG8_SCHED;
            PG8_LDB(B1, 1, 1); PG8_STAGE(PG8_SB(1, 0), b3, voffB);
            PG8_BAR; PG8_WAIT_L(0); PG8_MMA(0, 1, At, B1); PG8_BAR;
            PG8_LDA(At, 1, 1); PG8_STAGE(PG8_SA(1, 0), a3, voffA);
            PG8_BAR; PG8_WAIT_L(0); PG8_MMA(1, 0, At, B0); PG8_BAR; PG8_SCHED;
            PG8_STAGE(PG8_SB(1, 1), b3 + hstep, voffB);
            PG8_WAIT_V(6); PG8_BAR; PG8_MMA(1, 1, At, B1); PG8_BAR;
        }
        PG8_STAMP();
        if constexpr (!Epi::AFTER_DRAIN) { E(acc, cur, wr, wc, fr, fq); S.done(cur); }
        PG8_STAMP();
        if (!has_next) break;
#pragma unroll
        for (int a = 0; a < 2; ++a)
#pragma unroll
            for (int b = 0; b < 2; ++b)
#pragma unroll
                for (int m = 0; m < 4; ++m)
#pragma unroll
                    for (int n = 0; n < 2; ++n) acc[a][b][m][n] = (f32x4){0.f, 0.f, 0.f, 0.f};
        cur = nxt; cA = nA; cB = nB; ++ui;
    }
    PG8_WAIT_V(0);
    if (wr == 0) PG8_BAR;
    PG8_BAR;
    if constexpr (Epi::AFTER_DRAIN) { E.fused(acc, cur, wr, wc, fr, fq, lds, wid, lane); S.done(cur); }
    PG8_STAMP();
    if (STAMP && wid == 0) { stamps[lane] = lane < nts ? (((unsigned long long)(unsigned)ts_hi << 32) | (unsigned)ts_lo) : 0ull;
        if (lane == 62) stamps[62] = rt_entry; if (lane == 63) stamps[63] = (unsigned long long)wall_clock64(); }
#undef PG8_STAMP
#undef PG8_SA
#undef PG8_SB
#undef PG8_STAGE
#undef PG8_LDA
#undef PG8_LDB
#undef PG8_MMA
#undef PG8_WAIT_V
#undef PG8_WAIT_L
#undef PG8_BAR
#undef PG8_SCHED
}
}
struct EpiResF32 {
  static constexpr bool PERM = false, AFTER_DRAIN = false;
  float* C; const float* X;
  __device__ __forceinline__ void operator()(const pg8::f32x4 (&acc)[2][2][4][2], const pg8::Unit& u, int wr, int wc, int fr, int fq) const {
    const int row0 = u.pm * 256 + wr * 64 + fr, col0 = u.pn * 256 + wc * 32 + 4 * fq;
#pragma unroll
    for (int ai = 0; ai < 2; ++ai)
#pragma unroll
      for (int m = 0; m < 4; ++m) {
        const size_t ro = (size_t)(row0 + ai * 128 + m * 16) * 1024 + col0;
#pragma unroll
        for (int bj = 0; bj < 2; ++bj)
#pragma unroll
          for (int n = 0; n < 2; ++n) {
            const size_t o = ro + bj * 128 + n * 16;
            const pg8::f32x4 xv = *(const pg8::f32x4*)(X + o);
            *(pg8::f32x4*)(C + o) = xv * 1.189207115f + acc[ai][bj][m][n];
          }
      }
  }
};

template <int TM, int TN, bool DEEP = true, class AL, class BL>
DI void gemm_kloop(f32x16 (&acc)[TM][TN], const int nk, AL aload, BL bload, unsigned char* smem) {
  constexpr int BM = 128 * TM, BN = 64 * TN;
  constexpr int STAGE = (BM + BN) * 144;
  const int tid = threadIdx.x, lane = tid & 63, w = tid >> 6, wr = w >> 1, wc = w & 1, l32 = lane & 31, h = lane >> 5;
  u32x4 ra0[2 * TM], rb0[TN], ra1[2 * TM], rb1[TN];
#define GLOAD(RA, RB, KT) { _Pragma("unroll") for (int i = 0; i < 2 * TM; ++i) { int c = tid + i * NTHR; RA[i] = aload(c >> 3, (c & 7) * 8, (KT)); } \
                            _Pragma("unroll") for (int i = 0; i < TN; ++i) { int c = tid + i * NTHR; RB[i] = bload(c >> 3, (c & 7) * 8, (KT)); } }
#define LSTORE(RA, RB, ST) { unsigned char* dA_ = smem + (ST) * STAGE; \
                            _Pragma("unroll") for (int i = 0; i < 2 * TM; ++i) { int c = tid + i * NTHR; *(u32x4*)(dA_ + (c >> 3) * 144 + (c & 7) * 16) = RA[i]; } \
                            _Pragma("unroll") for (int i = 0; i < TN; ++i) { int c = tid + i * NTHR; *(u32x4*)(dA_ + BM * 144 + (c >> 3) * 144 + (c & 7) * 16) = RB[i]; } }
#define COMPUTE(ST) { const unsigned char* sA = smem + (ST) * STAGE; const unsigned char* sB = sA + BM * 144; \
    _Pragma("unroll") for (int ks = 0; ks < 4; ++ks) { bf16x8 a[TM], b[TN]; \
      _Pragma("unroll") for (int tm = 0; tm < TM; ++tm) a[tm] = *(const bf16x8*)(sA + (wr * TM * 32 + tm * 32 + l32) * 144 + (ks * 2 + h) * 16); \
      _Pragma("unroll") for (int tn = 0; tn < TN; ++tn) b[tn] = *(const bf16x8*)(sB + (wc * TN * 32 + tn * 32 + l32) * 144 + (ks * 2 + h) * 16); \
      _Pragma("unroll") for (int tm = 0; tm < TM; ++tm) _Pragma("unroll") for (int tn = 0; tn < TN; ++tn) acc[tm][tn] = MFMA(a[tm], b[tn], acc[tm][tn]); } }
  if (!DEEP) {
    GLOAD(ra0, rb0, 0);
    __syncthreads();
    LSTORE(ra0, rb0, 0);
    __syncthreads();
    for (int kt = 0; kt < nk; ++kt) {
      const int cur = kt & 1;
      if (kt + 1 < nk) GLOAD(ra0, rb0, kt + 1);
      COMPUTE(cur);
      if (kt + 1 < nk) LSTORE(ra0, rb0, cur ^ 1);
      __syncthreads();
    }
    return;
  }
  GLOAD(ra0, rb0, 0);
  if (nk > 1) GLOAD(ra1, rb1, 1);
  __syncthreads();
  LSTORE(ra0, rb0, 0);
  __syncthreads();
  for (int kt = 0; kt < nk; kt += 2) {
    if (kt + 2 < nk) GLOAD(ra0, rb0, kt + 2);
    COMPUTE(0);
    if (kt + 1 < nk) LSTORE(ra1, rb1, 1);
    __syncthreads();
    if (kt + 1 >= nk) break;
    if (kt + 3 < nk) GLOAD(ra1, rb1, kt + 3);
    COMPUTE(1);
    if (kt + 2 < nk) LSTORE(ra0, rb0, 0);
    __syncthreads();
  }
#undef GLOAD
#undef LSTORE
#undef COMPUTE
}
template <int TM, int TN, class F>
DI void gemm_epi(f32x16 (&acc)[TM][TN], F f) {
  const int tid = threadIdx.x, lane = tid & 63, w = tid >> 6, wr = w >> 1, wc = w & 1, l32 = lane & 31, h = lane >> 5;
#pragma unroll
  for (int tm = 0; tm < TM; ++tm)
#pragma unroll
    for (int tn = 0; tn < TN; ++tn)
#pragma unroll
      for (int g = 0; g < 4; ++g)
        f(wr * TM * 32 + tm * 32 + 8 * g + 4 * h, wc * TN * 32 + tn * 32 + l32, acc[tm][tn][4 * g], acc[tm][tn][4 * g + 1], acc[tm][tn][4 * g + 2], acc[tm][tn][4 * g + 3]);
}
template <int TM, int TN, class F>
DI void gemm_epi_rows(f32x16 (&acc)[TM][TN], unsigned char* smem, F f) {
  const int tid = threadIdx.x, lane = tid & 63, w = tid >> 6, wr = w >> 1, wc = w & 1, l32 = lane & 31, h = lane >> 5;
  constexpr int RS = TN * 32 + 4;
  float* st = (float*)smem + w * (32 * RS);
#pragma unroll
  for (int tm = 0; tm < TM; ++tm) {
#pragma unroll
    for (int tn = 0; tn < TN; ++tn)
#pragma unroll
      for (int i = 0; i < 16; ++i) st[crow_(i, h) * RS + tn * 32 + l32] = acc[tm][tn][i];
    __builtin_amdgcn_s_waitcnt(0xc07f);
    constexpr int C4 = TN * 8;
#pragma unroll
    for (int i = 0; i < (32 * C4) / 64; ++i) {
      const int idx = i * 64 + lane, row = idx / C4, c4 = idx % C4;
      const f32x4 v = *(const f32x4*)(st + row * RS + c4 * 4);
      f(wr * TM * 32 + tm * 32 + row, wc * TN * 32 + c4 * 4, v);
    }
    __builtin_amdgcn_s_waitcnt(0xc07f);
  }
}
template <int TM, int TN, class F>
DI void gemm_epi_cols(f32x16 (&acc)[TM][TN], unsigned char* smem, F f) {
  const int tid = threadIdx.x, lane = tid & 63, w = tid >> 6, wr = w >> 1, wc = w & 1, l32 = lane & 31, h = lane >> 5;
  constexpr int RS = TN * 32 + 4;
  float* st = (float*)smem + w * (32 * RS);
#pragma unroll
  for (int tm = 0; tm < TM; ++tm) {
#pragma unroll
    for (int tn = 0; tn < TN; ++tn)
#pragma unroll
      for (int i = 0; i < 16; ++i) st[crow_(i, h) * RS + tn * 32 + l32] = acc[tm][tn][i];
    __builtin_amdgcn_s_waitcnt(0xc07f);
#pragma unroll
    for (int i = 0; i < TN * 2; ++i) {
      const int idx = i * 64 + lane, col = idx % (TN * 32), rg = idx / (TN * 32);
      float v[8];
#pragma unroll
      for (int r = 0; r < 8; ++r) v[r] = st[(rg * 8 + r) * RS + col];
      f(wr * TM * 32 + tm * 32 + rg * 8, wc * TN * 32 + col, v);
    }
    __builtin_amdgcn_s_waitcnt(0xc07f);
  }
}
template <int TM, int TN>
DI void zero_acc(f32x16 (&acc)[TM][TN]) {
#pragma unroll
  for (int a = 0; a < TM; ++a)
#pragma unroll
    for (int b = 0; b < TN; ++b) acc[a][b] = zero16();
}
DI u32x4 ldg16(const bf16_t* p) { return *(const u32x4*)p; }

DI void transpose_tile(const Params& P, int tile, unsigned char* smem) {
  const int tid = threadIdx.x;
  float* tl = (float*)smem;
  int j = 0;
  while (j + 1 < P.njobs && P.jobs[j + 1].tile0 <= tile) ++j;
  const float* src = P.jobs[j].src; bf16_t* dst = P.jobs[j].dst;
  const int ld = P.jobs[j].ld, col0 = P.jobs[j].col0, ncols = P.jobs[j].ncols, K = P.jobs[j].K;
  const int lt = tile - P.jobs[j].tile0, nkt = K >> 6, nt = lt / nkt, k0 = (lt - nt * nkt) << 6;
  __syncthreads();
#pragma unroll
  for (int i = 0; i < 8; ++i) {
    int idx = tid + i * NTHR, kk = idx >> 6, nn = idx & 63, n = nt * 64 + nn;
    tl[kk * 65 + nn] = (n < ncols) ? src[(size_t)(k0 + kk) * ld + col0 + n] : 0.f;
  }
  __syncthreads();
#pragma unroll
  for (int i = 0; i < 4; ++i) {
    int idx = tid + i * NTHR, nn = idx >> 5, kp = idx & 31;
    *(unsigned*)(dst + (size_t)(nt * 64 + nn) * K + k0 + kp * 2) = pack2(tl[(kp * 2) * 65 + nn], tl[(kp * 2 + 1) * 65 + nn]);
  }
}
DI void phase_prep(const Params& P, unsigned char* smem) {
  const int tid = threadIdx.x;
  for (int tile = blockIdx.x; tile < P.ntiles_early; tile += gridDim.x) transpose_tile(P, tile, smem);
  {
    const float* x = P.in[0]; bf16_t* xb = (bf16_t*)(P.ws + WS_XB);
    for (size_t i = (size_t)blockIdx.x * NTHR + tid; i < (size_t)T * DM / 8; i += (size_t)gridDim.x * NTHR) {
      f32x4 a = *(const f32x4*)(x + i * 8), b = *(const f32x4*)(x + i * 8 + 4);
      *(u32x4*)(xb + i * 8) = cvt8(a, b);
    }
    for (int i = blockIdx.x * NTHR + tid; i < 2 * 16384 / 8; i += gridDim.x * NTHR) {
      const int which = i >> 11, e = (i & 2047) * 8;
      const float* s = P.in[20 + which] + e;
      *(u32x4*)((bf16_t*)(P.ws + (which ? SM_SK2 : SM_SK1)) + e) = cvt8(*(const f32x4*)s, *(const f32x4*)(s + 4));
    }
  }
  if (blockIdx.x < 16) {
    const int which = tid >> 8, n = tid & 255, kb = blockIdx.x * 128;
    const float* pos = P.in[3 + which]; const float* w1 = P.in[which ? 7 : 5];
    float s = 0.f;
    for (int k = kb; k < kb + 128; ++k) s += pos[k] * w1[(size_t)k * 256 + n];
    ((float*)(P.ws + SM_CBIAS))[blockIdx.x * 512 + tid] = s;
  }
  if (blockIdx.x == 16 && tid == 0) {
    float a = 0.f, b = 0.f;
    for (int i = 0; i < 64; ++i) { a += P.in[9][i] * P.in[10][i]; b += P.in[11][i] * P.in[12][i]; }
    *(float*)(P.ws + SM_LAM) = expf(a) - expf(b) + 0.2f;
  }
}

DI void phase_inproj(const Params& P, unsigned char* smem) {
  const bf16_t* xb = (const bf16_t*)(P.ws + WS_XB);
  const bf16_t* wt = (const bf16_t*)(P.ws + WS_WINR);
  bf16_t* proj = (bf16_t*)(P.ws + R_PROJ);
  bf16_t* vT = (bf16_t*)(P.ws + R_VT);
  const int wc = (threadIdx.x >> 6) & 1;
  for (int tile = blockIdx.x; tile < 64 * 12; tile += gridDim.x) {
    const int mt = tile / 12, nt = tile - mt * 12;
    const int m0 = mt * 256, n0 = nt * 256;
    f32x16 acc[2][4]; zero_acc(acc);
    gemm_kloop<2, 4, false>(acc, 16,
      [&](int r, int ko, int kt) { return ldg16(xb + (size_t)(m0 + r) * DM + kt * 64 + ko); },
      [&](int r, int ko, int kt) { return ldg16(wt + (size_t)min(n0 + r, 2943) * DM + kt * 64 + ko); }, smem);
    const int seg = nt * 2 + wc;
    if (seg < 17) {
      const float sc = (seg < 4 || (seg >= 8 && seg < 12)) ? 0.125f : 1.f;
      const bool sg = (seg == 16);
      gemm_epi_rows<2, 4>(acc, smem, [&](int m, int n, f32x4 v) {
        if (sg) { v[0] = sigmoidf_(v[0]); v[1] = sigmoidf_(v[1]); v[2] = sigmoidf_(v[2]); v[3] = sigmoidf_(v[3]); }
        else v *= sc;
        u32x2 o = {pack2(v[0], v[1]), pack2(v[2], v[3])};
        *(u32x2*)(proj + (size_t)(m0 + m) * PJ + n0 + n) = o;
      });
    } else if (seg < 23) {
      gemm_epi_cols<2, 4>(acc, smem, [&](int m, int n, const float (&v)[8]) {
        const int mm = m0 + m, b = mm >> 11, sq = mm & 2047, c = n0 + n - 2176;
        u32x4 o = {pack2(v[0], v[1]), pack2(v[2], v[3]), pack2(v[4], v[5]), pack2(v[6], v[7])};
        *(u32x4*)(vT + ((size_t)(b * 768 + c) * SEQ + sq)) = o;
      });
    }
  }
}

DI void cmp1_tile(const Params& P, int tile, unsigned char* smem) {
  const bf16_t* proj = (const bf16_t*)(P.ws + R_PROJ);
  bf16_t* hid = (bf16_t*)(P.ws + R_HID);
  const float* cb = (const float*)(P.ws + SM_CBIAS);
  {
    const int which = tile >> 4, mt = (tile >> 1) & 7, nt = tile & 1;
    const bf16_t* w1 = (const bf16_t*)(P.ws + (which ? WS_CW1V : WS_CW1K));
    const int colbase = which ? 896 : 512;
    f32x16 acc[2][2]; zero_acc(acc);
    gemm_kloop<2, 2>(acc, 32,
      [&](int r, int ko, int kt) {
        const int m = mt * 256 + r, bg = m >> 7, c = min(m & 127, 126), b = bg >> 1, g = bg & 1;
        return ldg16(proj + (size_t)(b * SEQ + c * 16 + kt) * PJ + colbase + g * 64 + ko); },
      [&](int r, int ko, int kt) { return ldg16(w1 + (size_t)(nt * 128 + r) * 2048 + kt * 64 + ko); }, smem);
    gemm_epi_rows<2, 2>(acc, smem, [&](int m, int n, f32x4 v) {
      const int nn = nt * 128 + n;
      f32x4 bias = {0.f, 0.f, 0.f, 0.f};
#pragma unroll
      for (int j = 0; j < 16; ++j) bias += *(const f32x4*)(cb + j * 512 + which * 256 + nn);
      v += bias;
      u32x2 o = {pack2(geluf_(v[0]), geluf_(v[1])), pack2(geluf_(v[2]), geluf_(v[3]))};
      *(u32x2*)(hid + ((size_t)which * 2048 + mt * 256 + m) * 256 + nn) = o;
    });
  }
}
DI void cmp2_tile(const Params& P, int tile, unsigned char* smem) {
  const bf16_t* hid = (const bf16_t*)(P.ws + R_HID);
  bf16_t* kc = (bf16_t*)(P.ws + R_KC);
  bf16_t* vcT = (bf16_t*)(P.ws + R_VCT);
  {
    const int which = tile >> 3, mt = tile & 7;
    const bf16_t* w2 = (const bf16_t*)(P.ws + (which ? SM_CW2V : SM_CW2K));
    f32x16 acc[2][1]; zero_acc(acc);
    gemm_kloop<2, 1>(acc, 4,
      [&](int r, int ko, int kt) { return ldg16(hid + ((size_t)which * 2048 + mt * 256 + r) * 256 + kt * 64 + ko); },
      [&](int r, int ko, int kt) { return ldg16(w2 + (size_t)r * 256 + kt * 64 + ko); }, smem);
    gemm_epi<2, 1>(acc, [&](int m, int n, float v0, float v1, float v2, float v3) {
      const int mm = mt * 256 + m, bg = mm >> 7, c = mm & 127;
      if (which == 0) {
        bf16_t* d = kc + ((size_t)bg * 128 + c) * 64 + n;
        d[0] = f2bf(v0); d[64] = f2bf(v1); d[128] = f2bf(v2); d[192] = f2bf(v3);
      } else {
        u32x2 v = {pack2(v0, v1), pack2(v2, v3)};
        *(u32x2*)(vcT + ((size_t)bg * 64 + n) * 128 + c) = v;
      }
    });
  }
}

DI void phase_cmp2(const Params& P, unsigned char* smem) {
  for (int tile = blockIdx.x; tile < 16; tile += gridDim.x) cmp2_tile(P, tile, smem);
}
DI int crow(int i, int h) { return (i & 3) + 8 * (i >> 2) + 4 * h; }
DI bf16x8 pack8(const f32x16& x, int s) {
  u32x4 p;
  p[0] = pack2(x[8 * s + 0], x[8 * s + 1]); p[1] = pack2(x[8 * s + 2], x[8 * s + 3]);
  p[2] = pack2(x[8 * s + 4], x[8 * s + 5]); p[3] = pack2(x[8 * s + 6], x[8 * s + 7]);
  return __builtin_bit_cast(bf16x8, p);
}
DI void qk64(f32x16* s, const unsigned char* sK, int rstride, const bf16x8 (&q)[4], int l32, int h) {
#pragma unroll
  for (int kt = 0; kt < 2; ++kt) {
    s[kt] = zero16();
#pragma unroll
    for (int ks = 0; ks < 4; ++ks) {
      bf16x8 a = *(const bf16x8*)(sK + (kt * 32 + l32) * rstride + (ks * 2 + h) * 16);
      s[kt] = MFMA(a, q[ks], s[kt]);
    }
  }
}
template <int NDV>
DI void pv64(f32x16 (&o)[NDV], const f32x16* p, const unsigned char* sV, int rstride, int kofs, int l32, int h) {
#pragma unroll
  for (int ks = 0; ks < 4; ++ks) {
    bf16x8 pb = pack8(p[ks >> 1], ks & 1);
#pragma unroll
    for (int dvt = 0; dvt < NDV; ++dvt) {
      const unsigned char* r = sV + (dvt * 32 + l32) * rstride + (kofs + ks * 16 + 4 * h) * 2;
      s16x4 lo = *(const s16x4*)r, hi = *(const s16x4*)(r + 16);
      bf16x8 a = __builtin_shufflevector(lo, hi, 0, 1, 2, 3, 4, 5, 6, 7);
      o[dvt] = MFMA(a, pb, o[dvt]);
    }
  }
}
template <int NDV>
DI void softmax64(f32x16 (&s)[2], float& m, float& l, f32x16 (&o)[NDV], int t, int kbase, float slope2, bool masked, bool sel, int hi, int h) {
  const float c0 = slope2 * (float)(kbase + 4 * h);
  const f32x2 B0 = {0.f, slope2}, B1 = {2.f * slope2, 3.f * slope2};
  const f32x2 L2 = {1.44269504f, 1.44269504f};
#pragma unroll
  for (int kt = 0; kt < 2; ++kt)
#pragma unroll
    for (int g = 0; g < 4; ++g) {
      const float A = fmaf(slope2, (float)(kt * 32 + 8 * g), c0);
      const f32x2 Av = {A, A};
      f32x2 v0 = {s[kt][4 * g], s[kt][4 * g + 1]}, v1 = {s[kt][4 * g + 2], s[kt][4 * g + 3]};
      v0 = __builtin_elementwise_fma(v0, L2, Av + B0);
      v1 = __builtin_elementwise_fma(v1, L2, Av + B1);
      s[kt][4 * g] = v0[0]; s[kt][4 * g + 1] = v0[1]; s[kt][4 * g + 2] = v1[0]; s[kt][4 * g + 3] = v1[1];
    }
  if (masked) {
    const int tr = t - kbase - 4 * h;
    const unsigned hie = sel ? (unsigned)hi : 0u;
#pragma unroll
    for (int kt = 0; kt < 2; ++kt)
#pragma unroll
      for (int i = 0; i < 16; ++i) {
        const int K = kt * 32 + (i & 3) + 8 * (i >> 2);
        s[kt][i] = ((unsigned)(tr - K) < hie) ? s[kt][i] : NEGBIG;
      }
  }
  float mx = NEGBIG;
#pragma unroll
  for (int kt = 0; kt < 2; ++kt)
#pragma unroll
    for (int i = 0; i < 16; i += 2) mx = fmaxf(fmaxf(s[kt][i], s[kt][i + 1]), mx);
  mx = fmaxf(mx, __shfl_xor(mx, 32));
  const bool need = mx > m + 8.f;
  if (__builtin_amdgcn_ballot_w64(need) != 0ull) {
    const float mn = need ? mx : m;
    const float alpha = __builtin_amdgcn_exp2f(m - mn);
    l *= alpha;
#pragma unroll
    for (int d = 0; d < NDV; ++d) o[d] *= alpha;
    m = mn;
  }
  const f32x2 mv = {m, m};
  f32x2 ls2 = {0.f, 0.f};
#pragma unroll
  for (int kt = 0; kt < 2; ++kt)
#pragma unroll
    for (int i = 0; i < 16; i += 2) {
      const f32x2 d = f32x2{s[kt][i], s[kt][i + 1]} - mv;
      const f32x2 e = {__builtin_amdgcn_exp2f(d[0]), __builtin_amdgcn_exp2f(d[1])};
      s[kt][i] = e[0]; s[kt][i + 1] = e[1];
      ls2 += e;
    }
  l += ls2[0] + ls2[1];
}

DI void nsa_item(const Params& P, int item, unsigned char* smem) {
  const int tid = threadIdx.x, lane = tid & 63, w = __builtin_amdgcn_readfirstlane(tid >> 6), l32 = lane & 31, h = lane >> 5;
  const int qb = item & 31, bg = item >> 5, b = bg >> 1, g = bg & 1;
  const int hw = w & 3, qt = w >> 2, head = g * 4 + hw;
  const int q64 = qt * 32 + l32, t = qb * 64 + q64;
  const size_t token = (size_t)b * SEQ + t;
  const float slope = exp2f(-(float)(head + 1));
  const float slope2 = slope * 1.44269504f;
  const bf16_t* proj = (const bf16_t*)(P.ws + R_PROJ);
  const bf16_t* vT = (const bf16_t*)(P.ws + R_VT);
  unsigned char* sK = smem;
  unsigned char* sV = smem + 18432;
  float* imp = (float*)(smem + 36864);
  unsigned* umask = (unsigned*)(smem + 36864 + 8448);

  bf16x8 q[4];
#pragma unroll
  for (int ks = 0; ks < 4; ++ks) q[ks] = *(const bf16x8*)(proj + token * PJ + head * 64 + ks * 16 + h * 8);
  const float g0 = __uint_as_float((unsigned)proj[token * PJ + 2048 + head * 3 + 0] << 16);
  const float g1 = __uint_as_float((unsigned)proj[token * PJ + 2048 + head * 3 + 1] << 16);
  const float g2 = __uint_as_float((unsigned)proj[token * PJ + 2048 + head * 3 + 2] << 16);

  __syncthreads();
  for (int i = tid; i < 64 * 33; i += NTHR) imp[i] = 0.f;
  if (tid == 0) *umask = 0u;
  {
    const bf16_t* kc = (const bf16_t*)(P.ws + R_KC) + (size_t)bg * 128 * 64;
    const bf16_t* vc = (const bf16_t*)(P.ws + R_VCT) + (size_t)bg * 64 * 128;
#pragma unroll
    for (int i = 0; i < 2; ++i) {
      int c = tid + i * NTHR;
      *(u32x4*)(sK + (c >> 3) * 144 + (c & 7) * 16) = ldg16(kc + (c >> 3) * 64 + (c & 7) * 8);
      *(u32x4*)(sV + (c >> 4) * 272 + (c & 15) * 16) = ldg16(vc + (c >> 4) * 128 + (c & 15) * 8);
    }
  }
  __syncthreads();
  f32x16 comb[2];
  {
    f32x16 sc[4];
    qk64(sc, sK, 144, q, l32, h);
    qk64(sc + 2, sK + 64 * 144, 144, q, l32, h);
    float mx = NEGBIG;
#pragma unroll
    for (int kt = 0; kt < 4; ++kt)
#pragma unroll
      for (int i = 0; i < 16; ++i) {
        const int c = kt * 32 + crow(i, h);
        const int dist = t - (c * 16 + 31);
        const float r = (dist >= 0) ? sc[kt][i] - slope * (float)dist : NEGBIG;
        sc[kt][i] = r;
        mx = fmaxf(mx, r);
      }
    mx = fmaxf(mx, __shfl_xor(mx, 32));
    float ls = 0.f;
#pragma unroll
    for (int kt = 0; kt < 4; ++kt)
#pragma unroll
      for (int i = 0; i < 16; ++i) {
        const float r = (sc[kt][i] > -1.0e29f) ? __expf(sc[kt][i] - mx) : 0.f;
        sc[kt][i] = r;
        ls += r;
      }
    ls += __shfl_xor(ls, 32);
    const float inv = 1.f / fmaxf(ls, 1.0e-30f);
#pragma unroll
    for (int kt = 0; kt < 4; ++kt)
#pragma unroll
      for (int gq = 0; gq < 4; ++gq) {
        const float p0 = sc[kt][4 * gq] * inv, p1 = sc[kt][4 * gq + 1] * inv, p2 = sc[kt][4 * gq + 2] * inv, p3 = sc[kt][4 * gq + 3] * inv;
        sc[kt][4 * gq] = p0; sc[kt][4 * gq + 1] = p1; sc[kt][4 * gq + 2] = p2; sc[kt][4 * gq + 3] = p3;
        const int j = 8 * kt + 2 * gq + h;
        const float sp = 0.5f * p3;
        atomicAdd(&imp[q64 * 33 + j], p0 + p1 + p2 + sp);
        atomicAdd(&imp[q64 * 33 + j + 1], sp);
      }
    f32x16 o[2]; o[0] = zero16(); o[1] = zero16();
    pv64<2>(o, sc, sV, 272, 0, l32, h);
    pv64<2>(o, sc + 2, sV, 272, 64, l32, h);
    comb[0] = o[0] * g0; comb[1] = o[1] * g0;
  }
  __syncthreads();
  const int cur = qb;
  unsigned mask = 1u | (1u << cur) | (cur >= 1 ? (1u << (cur - 1)) : 0u);
  {
    float tv[5]; int ti[5];
#pragma unroll
    for (int k = 0; k < 5; ++k) { tv[k] = -1.f; ti[k] = -1; }
    for (int j = 1; j <= cur - 2; ++j) {
      float v = imp[q64 * 33 + j]; int vi = j;
#pragma unroll
      for (int k = 0; k < 5; ++k) {
        const bool gt = v > tv[k];
        const float nv = gt ? tv[k] : v; const int ni = gt ? ti[k] : vi;
        tv[k] = gt ? v : tv[k]; ti[k] = gt ? vi : ti[k];
        v = nv; vi = ni;
      }
    }
#pragma unroll
    for (int k = 0; k < 5; ++k) if (ti[k] >= 0) mask |= (1u << ti[k]);
  }
  {
    unsigned um = mask;
#pragma unroll
    for (int off = 32; off >= 1; off >>= 1) um |= (unsigned)__shfl_xor((int)um, off);
    if (lane == 0) atomicOr(umask, um);
  }
  __syncthreads();
  const unsigned un = *umask;
#pragma unroll 1
  for (int br = 0; br < 2; ++br) {
    const int kcol = (br == 0 ? 640 : 768) + g * 64;
    const int vrow = (br == 0 ? 0 : 128) + g * 64;
    const int j0 = (br == 0) ? 0 : max(0, cur - 8);
    const int hi = (br == 0) ? 0x7fffffff : 512;
    const unsigned upto = (cur >= 31) ? 0xffffffffu : ((2u << cur) - 1u);
    unsigned tmask = (br == 0) ? (un & upto) : (upto & ~((1u << j0) - 1u));
    float m = MINIT, l = 0.f;
    f32x16 o[2]; o[0] = zero16(); o[1] = zero16();
    const int lr = tid >> 3, lpart = tid & 7;
    const bf16_t* kbase = proj + ((size_t)b * SEQ + lr) * PJ + kcol + lpart * 8;
    const bf16_t* vbase = vT + ((size_t)(b * 768 + vrow + lr) * SEQ + lpart * 8);
    u32x4 rk, rv;
    int j = __builtin_ctz(tmask); tmask &= tmask - 1;
    rk = ldg16(kbase + (size_t)j * 64 * PJ); rv = ldg16(vbase + j * 64);
    __syncthreads();
    *(u32x4*)(sK + lr * 144 + lpart * 16) = rk; *(u32x4*)(sK + 9216 + lr * 144 + lpart * 16) = rv;
    __syncthreads();
    int st = 0;
#pragma unroll 1
    while (true) {
      const bool more = (tmask != 0u);
      int jn = 0;
      if (more) { jn = __builtin_ctz(tmask); tmask &= tmask - 1; rk = ldg16(kbase + (size_t)jn * 64 * PJ); rv = ldg16(vbase + jn * 64); }
      const unsigned char* cK = sK + st * 18432;
      f32x16 sc2[2];
      qk64(sc2, cK, 144, q, l32, h);
      const bool sel = (br == 0) ? (((mask >> j) & 1u) != 0u) : true;
      const int tw0 = qb * 64 + qt * 32;
      const bool fast = (br == 0) ? (j < cur && __builtin_amdgcn_ballot_w64(!sel) == 0ull)
                                  : (j * 64 + 63 <= tw0 && j * 64 >= tw0 + 31 - 511);
      softmax64<2>(sc2, m, l, o, t, j * 64, slope2, !fast, sel, hi, h);
      pv64<2>(o, sc2, cK + 9216, 144, 0, l32, h);
      if (!more) break;
      unsigned char* nK = sK + (st ^ 1) * 18432;
      *(u32x4*)(nK + lr * 144 + lpart * 16) = rk; *(u32x4*)(nK + 9216 + lr * 144 + lpart * 16) = rv;
      __syncthreads();
      st ^= 1; j = jn;
    }
    l += __shfl_xor(l, 32);
    const float scl = (br == 0 ? g1 : g2) / fmaxf(l, 1.0e-30f);
    comb[0] += o[0] * scl; comb[1] += o[1] * scl;
  }
  bf16_t* on = (bf16_t*)(P.ws + R_ONSA) + token * 512 + head * 64;
#pragma unroll
  for (int dvt = 0; dvt < 2; ++dvt)
#pragma unroll
    for (int gq = 0; gq < 4; ++gq) {
      u32x2 v = {pack2(comb[dvt][4 * gq], comb[dvt][4 * gq + 1]), pack2(comb[dvt][4 * gq + 2], comb[dvt][4 * gq + 3])};
      *(u32x2*)(on + dvt * 32 + 8 * gq + 4 * h) = v;
    }
}

DI void diff_item(const Params& P, int item, unsigned char* smem) {
  const int tid = threadIdx.x, lane = tid & 63, w = __builtin_amdgcn_readfirstlane(tid >> 6), l32 = lane & 31, h = lane >> 5;
  const int qb = item & 15, bh = item >> 4, b = bh >> 2, head = bh & 3;
  const int map = w >> 2, qt = w & 3;
  const int t = qb * 128 + qt * 32 + l32;
  const size_t token = (size_t)b * SEQ + t;
  const float slope2 = exp2f(-2.f * (float)(head + 1)) * 1.44269504f;
  const bf16_t* proj = (const bf16_t*)(P.ws + R_PROJ);
  const bf16_t* vT = (const bf16_t*)(P.ws + R_VT);
  unsigned char* sK1 = smem; unsigned char* sK2 = smem + 9216; unsigned char* sV = smem + 18432;
  bf16x8 q[4];
#pragma unroll
  for (int ks = 0; ks < 4; ++ks) q[ks] = *(const bf16x8*)(proj + token * PJ + 1024 + map * 256 + head * 64 + ks * 16 + h * 8);
  float m = MINIT, l = 0.f;
  f32x16 o[4];
#pragma unroll
  for (int d = 0; d < 4; ++d) o[d] = zero16();
  const int tmax_w = qb * 128 + qt * 32 + 31;
  const int lr = tid >> 3, lpart = tid & 7;
  const bf16_t* kbase = proj + ((size_t)b * SEQ + lr) * PJ + 1536 + head * 64 + lpart * 8;
  const bf16_t* vbase0 = vT + ((size_t)(b * 768 + 256 + head * 128 + lr) * SEQ + lpart * 8);
  const bf16_t* vbase1 = vbase0 + (size_t)64 * SEQ;
  const int nj = 2 * qb + 2;
#pragma unroll 1
  for (int j = 0; j < nj; ++j) {
    __syncthreads();
    {
      const size_t ko = (size_t)j * 64 * PJ; const int vo = j * 64;
      const u32x4 rk1 = ldg16(kbase + ko), rk2 = ldg16(kbase + ko + 256), rv0 = ldg16(vbase0 + vo), rv1 = ldg16(vbase1 + vo);
      *(u32x4*)(sK1 + lr * 144 + lpart * 16) = rk1; *(u32x4*)(sK2 + lr * 144 + lpart * 16) = rk2;
      *(u32x4*)(sV + lr * 144 + lpart * 16) = rv0; *(u32x4*)(sV + (64 + lr) * 144 + lpart * 16) = rv1;
    }
    __syncthreads();
    if (j * 64 <= tmax_w) {
      f32x16 sc2[2];
      qk64(sc2, map ? sK2 : sK1, 144, q, l32, h);
      softmax64<4>(sc2, m, l, o, t, j * 64, slope2, !(j * 64 + 63 <= tmax_w - 31), true, 0x7fffffff, h);
      pv64<4>(o, sc2, sV, 144, 0, l32, h);
    }
  }
  l += __shfl_xor(l, 32);
  const float inv = 1.f / fmaxf(l, 1.0e-30f);
  __syncthreads();
  float* ex = (float*)smem;
  if (map == 1) {
#pragma unroll
    for (int d = 0; d < 4; ++d)
#pragma unroll
      for (int i = 0; i < 16; ++i) ex[(qt * 64 + d * 16 + i) * 64 + lane] = o[d][i] * inv;
  }
  __syncthreads();
  if (map == 0) {
    const float lam = __uint_as_float(__hip_atomic_load((const unsigned*)(P.ws + SM_LAM), __ATOMIC_RELAXED, __HIP_MEMORY_SCOPE_AGENT));
    float ss = 0.f;
#pragma unroll
    for (int d = 0; d < 4; ++d)
#pragma unroll
      for (int i = 0; i < 16; ++i) {
        const float v = o[d][i] * inv - lam * ex[(qt * 64 + d * 16 + i) * 64 + lane];
        o[d][i] = v; ss += v * v;
      }
    ss += __shfl_xor(ss, 32);
    const float r = rsqrtf(ss * (1.f / 128.f) + 1.0e-5f) * 0.8f;
    const float* ng = P.in[13];
    bf16_t* od = (bf16_t*)(P.ws + R_ODIFF) + token * 512 + head * 128;
#pragma unroll
    for (int d = 0; d < 4; ++d)
#pragma unroll
      for (int gq = 0; gq < 4; ++gq) {
        const int dv = d * 32 + 8 * gq + 4 * h;
        const f32x4 gg = *(const f32x4*)(ng + dv);
        u32x2 v = {pack2(o[d][4 * gq] * r * gg[0], o[d][4 * gq + 1] * r * gg[1]), pack2(o[d][4 * gq + 2] * r * gg[2], o[d][4 * gq + 3] * r * gg[3])};
        *(u32x2*)(od + dv) = v;
      }
  }
}

DI void fp8_conv_item(const Params& P, int item);
#ifndef ATTN_SEL
#define ATTN_SEL 3
#endif
DI void phase_queue(const Params& P, unsigned char* smem, unsigned* qctr, const bool dyn) {
  const int ng = (P.ntiles_t - P.ntiles_early + 7) >> 3;
  const int nm = 512 + ng;
  const int total = 32 + 512 + nm;
  unsigned* done = qctr + 8;
  volatile int* sidx = (volatile int*)(smem + LDS_GEMM + 32);
  int idx = blockIdx.x;
  while (true) {
    if (dyn) {
      __syncthreads();
      if (threadIdx.x == 0) *sidx = (int)__hip_atomic_fetch_add(qctr, 1u, __ATOMIC_RELAXED, __HIP_MEMORY_SCOPE_AGENT);
      __syncthreads();
      idx = *sidx;
    }
    if (idx >= total) break;
    if (idx < 32) {
      cmp1_tile(P, idx, smem);
      if (dyn) {
        asm volatile("s_waitcnt vmcnt(0)" ::: "memory");
        __syncthreads();
        if (threadIdx.x == 0) {
          __builtin_amdgcn_fence(__ATOMIC_RELEASE, "agent");
          asm volatile("s_waitcnt vmcnt(0)" ::: "memory");
          __hip_atomic_fetch_add(&done[(idx >> 4) * 8 + ((idx >> 1) & 7)], 1u, __ATOMIC_RELAXED, __HIP_MEMORY_SCOPE_AGENT);
        }
      }
    } else {
      const int j = idx - 32;
      int kind, it;
      if (j < 1024) { kind = j & 1; it = j >> 1; } else { kind = 1; it = j - 512; }
      if (kind == 0) {
        if (ATTN_SEL & 1) { const int bh = it & 31, qb = 15 - (it >> 5); diff_item(P, bh * 16 + qb, smem); }
      } else if (it < 512) fp8_conv_item(P, it);
      else {
        const int t0 = P.ntiles_early + (it - 512) * 8;
        for (int tt = t0; tt < min(t0 + 8, P.ntiles_t); ++tt) transpose_tile(P, tt, smem);
      }
    }
    if (!dyn) idx += gridDim.x;
  }
  asm volatile("" ::: "memory");
  if (dyn && blockIdx.x < 16) {
    const int ct = blockIdx.x;
    if (threadIdx.x == 0) {
      unsigned sp = 0;
      while (__hip_atomic_load(&done[ct], __ATOMIC_RELAXED, __HIP_MEMORY_SCOPE_AGENT) < 2u) { __builtin_amdgcn_s_sleep(2); if (++sp > (1u << 22)) break; }
      __builtin_amdgcn_fence(__ATOMIC_ACQUIRE, "agent");
      asm volatile("s_waitcnt vmcnt(0)" ::: "memory");
    }
    __syncthreads();
    cmp2_tile(P, ct, smem);
  }
}
DI void phase_nsa(const Params& P, unsigned char* smem, unsigned* qctr, const bool dyn) {
  volatile int* sidx = (volatile int*)(smem + LDS_GEMM + 32);
  int idx = blockIdx.x;
  if (!(ATTN_SEL & 2)) return;
  while (true) {
    if (dyn) {
      __syncthreads();
      if (threadIdx.x == 0) *sidx = (int)__hip_atomic_fetch_add(qctr, 1u, __ATOMIC_RELAXED, __HIP_MEMORY_SCOPE_AGENT);
      __syncthreads();
      idx = *sidx;
    }
    if (idx >= 512) break;
    const int bg = idx & 15, qb = 31 - (idx >> 4);
    nsa_item(P, bg * 32 + qb, smem);
    if (!dyn) idx += gridDim.x;
  }
}

DI void phase_merge(const Params& P, unsigned char* smem) {
  const bf16_t* xb = (const bf16_t*)(P.ws + WS_XB);
  const bf16_t* wg = (const bf16_t*)(P.ws + WS_WGATE);
  const bf16_t* wbn = (const bf16_t*)(P.ws + WS_WBN);
  const bf16_t* wbd = (const bf16_t*)(P.ws + WS_WBD);
  const bf16_t* onsa = (const bf16_t*)(P.ws + R_ONSA);
  const bf16_t* odiff = (const bf16_t*)(P.ws + R_ODIFF);
  bf16_t* merged = (bf16_t*)(P.ws + R_MERGED);
#pragma unroll 1
  for (int tile = blockIdx.x; tile < 64 * 8; tile += gridDim.x) {
    const int mt = tile >> 3, nt = tile & 7, m0 = mt * 256, n0 = nt * 128;
    unsigned resp[2][2][8];
    unsigned gp[2][2][8];
    f32x16 va[2][2];
#pragma unroll
    for (int br = 0; br < 2; ++br) {
      zero_acc(va);
      const bf16_t* wgb = wg + (size_t)br * 1024 * DM;
      gemm_kloop<2, 2, false>(va, 16,
        [&](int r, int ko, int kt) { return ldg16(xb + (size_t)(m0 + r) * DM + kt * 64 + ko); },
        [&](int r, int ko, int kt) { return ldg16(wgb + (size_t)(n0 + r) * DM + kt * 64 + ko); }, smem);
#pragma unroll
      for (int tm = 0; tm < 2; ++tm)
#pragma unroll
        for (int tn = 0; tn < 2; ++tn)
#pragma unroll
          for (int i = 0; i < 8; ++i) gp[tm][tn][i] = pack2(sigmoidf_(va[tm][tn][2 * i]), sigmoidf_(va[tm][tn][2 * i + 1]));
      zero_acc(va);
      const bf16_t* oa = br ? odiff : onsa; const bf16_t* wb = br ? wbd : wbn;
      gemm_kloop<2, 2, false>(va, 8,
        [&](int r, int ko, int kt) { return ldg16(oa + (size_t)(m0 + r) * 512 + kt * 64 + ko); },
        [&](int r, int ko, int kt) { return ldg16(wb + (size_t)(n0 + r) * 512 + kt * 64 + ko); }, smem);
#pragma unroll
      for (int tm = 0; tm < 2; ++tm)
#pragma unroll
        for (int tn = 0; tn < 2; ++tn)
#pragma unroll
          for (int i = 0; i < 8; ++i) {
            const float p0 = bflo(gp[tm][tn][i]) * va[tm][tn][2 * i], p1 = bfhi(gp[tm][tn][i]) * va[tm][tn][2 * i + 1];
            if (br == 0) resp[tm][tn][i] = pack2(p0, p1);
            else { va[tm][tn][2 * i] = bflo(resp[tm][tn][i]) + p0; va[tm][tn][2 * i + 1] = bfhi(resp[tm][tn][i]) + p1; }
          }
    }
    gemm_epi_rows<2, 2>(va, smem, [&](int m, int n, f32x4 v) {
      u32x2 o = {pack2(v[0], v[1]), pack2(v[2], v[3])};
      *(u32x2*)(merged + (size_t)(m0 + m) * DM + n0 + n) = o;
    });
  }
}
DI void phase_outproj(const Params& P, unsigned char* smem) {
  pg8::Gemm g{(const pg8::bf16_t*)(P.ws + R_MERGED), (const pg8::bf16_t*)(P.ws + WS_WOUT), T, DM, DM};
  pg8::StaticOrder S; S.init(T, DM, (int)gridDim.x, (int)blockIdx.x);
  EpiResF32 E{P.out, P.in[0]};
  pg8::gemm_phase<EpiResF32, pg8::StaticOrder, false>((PG8_LAS unsigned char*)smem, g, S, E, nullptr);
  __syncthreads();
}
DI float wave_sum(float v) {
#pragma unroll
  for (int off = 32; off >= 1; off >>= 1) v += __shfl_xor(v, off);
  return v;
}
DI void phase_ln1(const Params& P) {
  const int tid = threadIdx.x, lane = tid & 63, w = tid >> 6;
  const float* gam = P.in[17]; const float* bet = P.in[18];
  bf16_t* hb = (bf16_t*)(P.ws + WS_XB);
  for (int row = blockIdx.x * 8 + w; row < T; row += gridDim.x * 8) {
    const float* r = P.out + (size_t)row * DM;
    f32x4 v[4];
    v[0] = *(const f32x4*)(r + lane * 8); v[1] = *(const f32x4*)(r + lane * 8 + 4); v[2] = *(const f32x4*)(r + 512 + lane * 8); v[3] = *(const f32x4*)(r + 512 + lane * 8 + 4);
    float s = 0.f;
#pragma unroll
    for (int i = 0; i < 4; ++i) s += v[i][0] + v[i][1] + v[i][2] + v[i][3];
    const float mu = wave_sum(s) * (1.f / 1024.f);
    float ss = 0.f;
#pragma unroll
    for (int i = 0; i < 4; ++i)
#pragma unroll
      for (int k = 0; k < 4; ++k) { const float d = v[i][k] - mu; ss += d * d; }
    const float rs = rsqrtf(wave_sum(ss) * (1.f / 1024.f) + 1.0e-5f);
#pragma unroll
    for (int i = 0; i < 4; ++i) {
      const int c = (i >> 1) * 512 + lane * 8 + (i & 1) * 4;
      const f32x4 gg = *(const f32x4*)(gam + c), bb = *(const f32x4*)(bet + c);
#pragma unroll
      for (int k = 0; k < 4; ++k) v[i][k] = (v[i][k] - mu) * rs * gg[k] + bb[k];
    }
    *(u32x4*)(hb + (size_t)row * DM + lane * 8) = cvt8(v[0], v[1]);
    *(u32x4*)(hb + (size_t)row * DM + 512 + lane * 8) = cvt8(v[2], v[3]);
  }
}

DI void fp8_conv_item(const Params& P, int item) {
  const int tid = threadIdx.x, lane = tid & 63, w = tid >> 6;
  for (int rr_ = 0; rr_ < 8; ++rr_) {
    const int row = item * 64 + w * 8 + rr_;
    const int which = row >> 14, rr = row & 16383;
    const float* sp = P.in[22 + which] + (size_t)rr * DM + lane * 16;
    f32x4 a[4];
#pragma unroll
    for (int i = 0; i < 4; ++i) a[i] = *(const f32x4*)(sp + i * 4);
    float mx = 0.f;
#pragma unroll
    for (int i = 0; i < 4; ++i)
#pragma unroll
      for (int k = 0; k < 4; ++k) mx = fmaxf(mx, fabsf(a[i][k]));
#pragma unroll
    for (int off = 32; off >= 1; off >>= 1) mx = fmaxf(mx, __shfl_xor(mx, off));
    const float sc = mx > 0.f ? 256.f / mx : 1.f;
    u32x4 o;
#pragma unroll
    for (int i = 0; i < 4; ++i) {
      int wd = 0;
      wd = __builtin_amdgcn_cvt_pk_fp8_f32(a[i][0] * sc, a[i][1] * sc, wd, false);
      wd = __builtin_amdgcn_cvt_pk_fp8_f32(a[i][2] * sc, a[i][3] * sc, wd, true);
      o[i] = (unsigned)wd;
    }
    *(u32x4*)(P.ws + (which ? R_VB8 : R_UB8) + (size_t)rr * 1024 + lane * 16) = o;
    if (lane == 0) ((float*)(P.ws + R_USC))[row] = mx > 0.f ? mx * (1.f / 256.f) : 1.f;
  }
}

DI void bubble16(float (&tv)[16], float v) {
#pragma unroll
  for (int k = 0; k < 16; ++k) { const float hi = fmaxf(tv[k], v); v = fminf(tv[k], v); tv[k] = hi; }
}
DI void ce_desc(float& a, float& b) { const float hi = fmaxf(a, b), lo = fminf(a, b); a = hi; b = lo; }
DI void bitonic_merge16_desc(float (&v)[16]) {
#pragma unroll
  for (int j = 8; j > 0; j >>= 1)
#pragma unroll
    for (int i = 0; i < 16; ++i) { const int l = i ^ j; if (l > i) ce_desc(v[i], v[l]); }
}
DI void sort16_desc(float (&v)[16]) {
#pragma unroll
  for (int k = 2; k <= 16; k <<= 1)
#pragma unroll
    for (int j = k >> 1; j > 0; j >>= 1)
#pragma unroll
      for (int i = 0; i < 16; ++i) { const int l = i ^ j; if (l > i) { if ((i & k) == 0) ce_desc(v[i], v[l]); else ce_desc(v[l], v[i]); } }
}
DI void merge_top16(float (&tv)[16], const float (&nv)[16]) {
#pragma unroll
  for (int i = 0; i < 16; ++i) tv[i] = fmaxf(tv[i], nv[15 - i]);
  bitonic_merge16_desc(tv);
}
DI void phase_route(const Params& P, unsigned char* smem) {
  const int tid = threadIdx.x, lane = tid & 63, w = tid >> 6, l32 = lane & 31, h = lane >> 5;
  const bf16_t* hb = (const bf16_t*)(P.ws + WS_XB);
  const bf16_t* wq = (const bf16_t*)(P.ws + WS_WQ);
  u32x2* rec = (u32x2*)(P.ws + R_EID);
  unsigned char* idxb = smem + 110592 + tid * 32;
  for (int tile = blockIdx.x; tile < 64 * 8; tile += gridDim.x) {
    const int mt = tile >> 3, hd = tile & 7, m0 = mt * 256;
    float top[2][16];
#pragma unroll
    for (int half = 0; half < 2; ++half) {
      const int n0 = hd * 256 + half * 128;
      f32x16 acc[2][2]; zero_acc(acc);
      gemm_kloop<2, 2>(acc, 16,
        [&](int r, int ko, int kt) { return ldg16(hb + (size_t)(m0 + r) * DM + kt * 64 + ko); },
        [&](int r, int ko, int kt) { return ldg16(wq + (size_t)(n0 + r) * DM + kt * 64 + ko); }, smem);
      gemm_epi<2, 2>(acc, [&](int m, int n, float v0, float v1, float v2, float v3) {
        bf16_t* d = (bf16_t*)smem + m * 136 + n;
        d[0] = f2bf(v0); d[136] = f2bf(v1); d[272] = f2bf(v2); d[408] = f2bf(v3);
      });
      {
        const bf16_t* sk = (const bf16_t*)(P.ws + (half ? SM_SK2 : SM_SK1));
#pragma unroll
        for (int i = 0; i < 4; ++i) {
          const int c = tid + i * NTHR;
          *(u32x4*)(smem + 69632 + (c >> 4) * 272 + (c & 15) * 16) = ldg16(sk + (c >> 4) * 128 + (c & 15) * 8);
        }
      }
      __syncthreads();
      float tv[16];
#pragma unroll
      for (int k = 0; k < 16; ++k) tv[k] = -3.0e38f;
#pragma unroll 1
      for (int ktp = 0; ktp < 2; ++ktp) {
        f32x16 st[2]; st[0] = zero16(); st[1] = zero16();
#pragma unroll 2
        for (int ks = 0; ks < 8; ++ks) {
          const bf16x8 qf = *(const bf16x8*)(smem + (w * 32 + l32) * 272 + (ks * 2 + h) * 16);
#pragma unroll
          for (int kk = 0; kk < 2; ++kk) {
            const bf16x8 a = *(const bf16x8*)(smem + 69632 + ((ktp * 2 + kk) * 32 + l32) * 272 + (ks * 2 + h) * 16);
            st[kk] = MFMA(a, qf, st[kk]);
          }
        }
#pragma unroll
        for (int kk = 0; kk < 2; ++kk) {
          float gsort[16];
#pragma unroll
          for (int i = 0; i < 16; ++i) {
            const unsigned key = (unsigned)((ktp * 2 + kk) * 32 + crow(i, h));
            gsort[i] = __uint_as_float((__float_as_uint(st[kk][i]) & ~127u) | key);
          }
          sort16_desc(gsort);
          merge_top16(tv, gsort);
        }
      }
      float pv[16];
#pragma unroll
      for (int k = 0; k < 16; ++k) pv[k] = __shfl_xor(tv[k], 32);
      merge_top16(tv, pv);
#pragma unroll
      for (int k = 0; k < 16; ++k) top[half][k] = tv[k];
    }
#pragma unroll
    for (int k = 0; k < 16; ++k) { idxb[k] = (unsigned char)(__float_as_uint(top[0][k]) & 127u); idxb[16 + k] = (unsigned char)(__float_as_uint(top[1][k]) & 127u); }
    float tv[16];
#pragma unroll
    for (int k = 0; k < 16; ++k) tv[k] = -3.0e38f;
#pragma unroll
    for (int a = 0; a < 16; ++a)
#pragma unroll
      for (int bb = 0; bb < 16; ++bb)
        if ((a + 1) * (bb + 1) <= 16) {
          const float sum = __uint_as_float(__float_as_uint(top[0][a]) & ~127u) + __uint_as_float(__float_as_uint(top[1][bb]) & ~127u);
          bubble16(tv, __uint_as_float((__float_as_uint(sum) & ~255u) | (unsigned)(a * 16 + bb)));
        }
    float e[16], es = 0.f;
    const float mx = __uint_as_float(__float_as_uint(tv[0]) & ~255u);
#pragma unroll
    for (int k = 0; k < 16; ++k) { e[k] = __expf(__uint_as_float(__float_as_uint(tv[k]) & ~255u) - mx); es += e[k]; }
    const float inv = 1.f / es;
    if (h == 0) {
      const size_t base = ((size_t)(m0 + w * 32 + l32) * 8 + hd) * 16;
#pragma unroll
      for (int k = 0; k < 16; ++k) {
        const unsigned code = __float_as_uint(tv[k]) & 255u;
        u32x2 rc = {(unsigned)idxb[code >> 4] * 128u + (unsigned)idxb[16 + (code & 15)], __float_as_uint(e[k] * inv)};
        rec[base + k] = rc;
      }
    }
    __syncthreads();
  }
}

template <int TK>
DI void gather_batch(const unsigned char* ub, const unsigned char* vb, const float* usc, const float* vsc, const u32x2* srt,
                     int base, int n, const f32x2 (&x)[8], f32x2 (&acc)[8], int lane, int sub, bool b5, bool b4, bool b3) {
#pragma unroll 1
  for (int i = 0; i < n; i += 8) {
    const bool valid = (i + sub) < n;
    const u32x2 rc = srt[base + (valid ? i + sub : i)];
    const int my_e = (int)rc[0];
    const float gate = valid ? __uint_as_float(rc[1]) : 0.f;
    u32x4 ur[8], vr[8];
#pragma unroll
    for (int e = 0; e < 8; ++e) {
      const int id = __builtin_amdgcn_readlane(my_e, 8 * e);
      ur[e] = *(const u32x4*)(ub + (size_t)id * 1024 + lane * 16);
    }
#pragma unroll
    for (int e = 0; e < 8; ++e) {
      const int id = __builtin_amdgcn_readlane(my_e, 8 * e);
      vr[e] = *(const u32x4*)(vb + (size_t)id * 1024 + lane * 16);
    }
    const float su = usc[my_e], sv = vsc[my_e];
    float d[8];
#pragma unroll
    for (int e = 0; e < 8; ++e) {
      f32x2 sacc = f32x2{0.f, 0.f};
#pragma unroll
      for (int k = 0; k < 4; ++k) {
        sacc = __builtin_elementwise_fma(__builtin_amdgcn_cvt_pk_f32_fp8((int)ur[e][k], false), x[2 * k], sacc);
        sacc = __builtin_elementwise_fma(__builtin_amdgcn_cvt_pk_f32_fp8((int)ur[e][k], true), x[2 * k + 1], sacc);
      }
      d[e] = sacc[0] + sacc[1];
    }
    float r4[4], r2[2];
#pragma unroll
    for (int k = 0; k < 4; ++k) { const float keep = b5 ? d[k + 4] : d[k], send = b5 ? d[k] : d[k + 4]; r4[k] = keep + __shfl_xor(send, 32); }
#pragma unroll
    for (int k = 0; k < 2; ++k) { const float keep = b4 ? r4[k + 2] : r4[k], send = b4 ? r4[k] : r4[k + 2]; r2[k] = keep + __shfl_xor(send, 16); }
    float r1;
    { const float keep = b3 ? r2[1] : r2[0], send = b3 ? r2[0] : r2[1]; r1 = keep + __shfl_xor(send, 8); }
    r1 += __shfl_xor(r1, 4); r1 += __shfl_xor(r1, 2); r1 += __shfl_xor(r1, 1);
    const float wv = gate * geluf_(r1 * su) * sv;
#pragma unroll
    for (int e = 0; e < 8; ++e) {
      const float wt = __builtin_bit_cast(float, __builtin_amdgcn_readlane(__builtin_bit_cast(int, wv), 8 * e));
      const f32x2 w2 = f32x2{wt, wt};
#pragma unroll
      for (int k = 0; k < 4; ++k) {
        acc[2 * k] = __builtin_elementwise_fma(__builtin_amdgcn_cvt_pk_f32_fp8((int)vr[e][k], false), w2, acc[2 * k]);
        acc[2 * k + 1] = __builtin_elementwise_fma(__builtin_amdgcn_cvt_pk_f32_fp8((int)vr[e][k], true), w2, acc[2 * k + 1]);
      }
    }
  }
}
DI void phase_gather(const Params& P, unsigned char* smem) {
  const int tid = threadIdx.x, lane = tid & 63, w = __builtin_amdgcn_readfirstlane(tid >> 6);
  const unsigned char* ub = P.ws + R_UB8;
  const unsigned char* vb = P.ws + R_VB8;
  const float* usc = (const float*)(P.ws + R_USC);
  const float* vsc = (const float*)(P.ws + R_VSC);
  const float* gam = P.in[24]; const float* bet = P.in[25];
  bf16_t* hb = (bf16_t*)(P.ws + WS_XB);
  const int sub = (lane >> 3) & 7;
  const bool b5 = (lane & 32) != 0, b4 = (lane & 16) != 0, b3 = (lane & 8) != 0;
  unsigned char* wbase = smem + w * 5120;
  u32x2* srt = (u32x2*)wbase;
  int* cnt = (int*)(wbase + 4096);
  int* off = (int*)(wbase + 4096 + 256);
  int* cur = (int*)(wbase + 4096 + 512);
  __syncthreads();
  for (int grp = blockIdx.x * 8 + w; grp < T / 4; grp += gridDim.x * 8) {
    const int tok0 = grp * 4;
    f32x2 x[4][8], acc[4][8];
#pragma unroll
    for (int tk = 0; tk < 4; ++tk) {
      const u32x2* rec = (const u32x2*)(P.ws + R_EID) + (size_t)(tok0 + tk) * 128;
      const u32x2 r0 = rec[lane], r1 = rec[64 + lane];
      if (lane < 16) cnt[tk * 16 + lane] = 0;
      const int c0 = (int)(r0[0] >> 11), c1 = (int)(r1[0] >> 11);
      atomicAdd(&cnt[tk * 16 + c0], 1); atomicAdd(&cnt[tk * 16 + c1], 1);
      if (lane < 16) {
        int sacc = 0;
        for (int j = 0; j < 16; ++j) sacc += (j < lane) ? cnt[tk * 16 + j] : 0;
        off[tk * 16 + lane] = sacc; cur[tk * 16 + lane] = sacc;
      }
      const int p0 = atomicAdd(&cur[tk * 16 + c0], 1);
      srt[tk * 128 + p0] = r0;
      const int p1 = atomicAdd(&cur[tk * 16 + c1], 1);
      srt[tk * 128 + p1] = r1;
      const float* rin = P.out + (size_t)(tok0 + tk) * DM + lane * 16;
      {
        f32x4 a[4];
#pragma unroll
        for (int i = 0; i < 4; ++i) a[i] = *(const f32x4*)(rin + i * 4);
        float s1 = 0.f;
#pragma unroll
        for (int i = 0; i < 4; ++i) s1 += a[i][0] + a[i][1] + a[i][2] + a[i][3];
        const float mu1 = wave_sum(s1) * (1.f / 1024.f);
        float s2 = 0.f;
#pragma unroll
        for (int i = 0; i < 4; ++i)
#pragma unroll
          for (int k = 0; k < 4; ++k) { const float dd = a[i][k] - mu1; s2 += dd * dd; }
        const float rs1 = rsqrtf(wave_sum(s2) * (1.f / 1024.f) + 1.0e-5f);
#pragma unroll
        for (int i = 0; i < 4; ++i) {
          const f32x4 gg = *(const f32x4*)(P.in[17] + lane * 16 + i * 4), bb = *(const f32x4*)(P.in[18] + lane * 16 + i * 4);
#pragma unroll
          for (int k = 0; k < 4; ++k) a[i][k] = (a[i][k] - mu1) * rs1 * gg[k] + bb[k];
          x[tk][2 * i] = f32x2{a[i][0], a[i][1]}; x[tk][2 * i + 1] = f32x2{a[i][2], a[i][3]};
        }
      }
#pragma unroll
      for (int k = 0; k < 8; ++k) acc[tk][k] = f32x2{0.f, 0.f};
    }
    __builtin_amdgcn_s_waitcnt(0xc07f);
#pragma unroll 1
    for (int c = 0; c < 8; ++c) {
#pragma unroll
      for (int tk = 0; tk < 4; ++tk) {
        const int n = __builtin_amdgcn_readfirstlane(cnt[tk * 16 + c]);
        const int base = __builtin_amdgcn_readfirstlane(off[tk * 16 + c]);
        gather_batch<0>(ub, vb, usc, vsc, srt + tk * 128, base, n, x[tk], acc[tk], lane, sub, b5, b4, b3);
      }
    }
#pragma unroll
    for (int tk = 0; tk < 4; ++tk) {
      float* r = P.out + (size_t)(tok0 + tk) * DM + lane * 16;
      float y[16];
      float s = 0.f;
#pragma unroll
      for (int k = 0; k < 8; ++k) { y[2 * k] = acc[tk][k][0] + LN_ALPHA * x[tk][k][0]; y[2 * k + 1] = acc[tk][k][1] + LN_ALPHA * x[tk][k][1]; s += y[2 * k] + y[2 * k + 1]; }
      const float mu = wave_sum(s) * (1.f / 1024.f);
      float ss = 0.f;
#pragma unroll
      for (int k = 0; k < 16; ++k) { const float dd = y[k] - mu; ss += dd * dd; }
      const float rs = rsqrtf(wave_sum(ss) * (1.f / 1024.f) + 1.0e-5f);
      f32x4 o[4];
#pragma unroll
      for (int i = 0; i < 4; ++i) {
        const int cc = lane * 16 + i * 4;
        const f32x4 gg = *(const f32x4*)(gam + cc), bb = *(const f32x4*)(bet + cc);
#pragma unroll
        for (int k = 0; k < 4; ++k) o[i][k] = (y[i * 4 + k] - mu) * rs * gg[k] + bb[k];
        *(f32x4*)(r + i * 4) = o[i];
      }
      *(u32x4*)(hb + (size_t)(tok0 + tk) * DM + lane * 16) = cvt8(o[0], o[1]);
      *(u32x4*)(hb + (size_t)(tok0 + tk) * DM + lane * 16 + 8) = cvt8(o[2], o[3]);
    }
  }
}

DI void phase_final(const Params& P, unsigned char* smem, const bool dry) {
  const bf16_t* hb = (const bf16_t*)(P.ws + WS_XB);
  const bf16_t* wpg = (const bf16_t*)(P.ws + WS_WPG);
  const bf16_t* wpp = (const bf16_t*)(P.ws + WS_WPP);
  const float* pp = P.in[1];
  for (int tile = blockIdx.x; tile < 64 * 8; tile += gridDim.x) {
    const int mt = tile >> 3, nt = tile & 7, m0 = mt * 256, n0 = nt * 128;
    f32x16 ag[2][2], ap[2][2]; zero_acc(ag); zero_acc(ap);
    gemm_kloop<2, 2>(ag, 16,
      [&](int r, int ko, int kt) { return ldg16(hb + (size_t)(m0 + r) * DM + kt * 64 + ko); },
      [&](int r, int ko, int kt) { return ldg16(wpg + (size_t)(n0 + r) * DM + kt * 64 + ko); }, smem);
    gemm_kloop<2, 2>(ap, 4,
      [&](int r, int ko, int kt) { const float* s = pp + (size_t)(m0 + r) * 256 + kt * 64 + ko; return cvt8(*(const f32x4*)s, *(const f32x4*)(s + 4)); },
      [&](int r, int ko, int kt) { return ldg16(wpp + (size_t)(n0 + r) * 256 + kt * 64 + ko); }, smem);
#pragma unroll
    for (int tm = 0; tm < 2; ++tm)
#pragma unroll
      for (int tn = 0; tn < 2; ++tn)
#pragma unroll
        for (int i = 0; i < 16; ++i) ag[tm][tn][i] = sigmoidf_(ag[tm][tn][i]) * ap[tm][tn][i];
    gemm_epi_rows<2, 2>(ag, smem, [&](int m, int n, f32x4 v) {
      const size_t o = (size_t)(m0 + m) * DM + n0 + n;
      const f32x4 hv = *(const f32x4*)(P.out + o);
      float* dst = dry ? (float*)(P.ws + WS_R + 32 * MiB) : P.out;
      *(f32x4*)(dst + o) = hv + v;
    });
  }
}

#define XB_TMO      128
#define XB_XCNT(j)  (256  + 64 * (j))
#define XB_XSUB(j)  (1280 + 64 * (j))
#define XB_XGEN(j)  (2304 + 64 * (j))
#define XB_TOP      3328
#define XB_TOPGEN   3392
#define XCD_BAR_WORDS 3456
#define XB_SPIN_CAP (1u << 18)
#define LAS __attribute__((address_space(3)))

__device__ __forceinline__ unsigned xb_ld(unsigned* p)              { return __hip_atomic_load(p, __ATOMIC_RELAXED, __HIP_MEMORY_SCOPE_AGENT); }
__device__ __forceinline__ unsigned xb_add(unsigned* p, unsigned v) { return __hip_atomic_fetch_add(p, v, __ATOMIC_RELAXED, __HIP_MEMORY_SCOPE_AGENT); }
__device__ __forceinline__ unsigned xb_xcc_id() { return (unsigned)__builtin_amdgcn_s_getreg((3 << 11) | 20) & 0xFu; }
#define XB_SPIN(cond, bar) do { unsigned _sp = 0; while (cond) { __builtin_amdgcn_s_sleep(1); \
    if ((++_sp & 255u) == 0u) { if (xb_ld(&(bar)[XB_TMO])) break; if (_sp > XB_SPIN_CAP) { atomicAdd(&(bar)[XB_TMO], 1u); break; } } } } while (0)

struct XcdBarrier {
    unsigned* bar; unsigned x;
    volatile LAS unsigned* st;
};

__device__ __forceinline__ XcdBarrier xcd_barrier_post(unsigned* bar, volatile LAS unsigned* st) {
    XcdBarrier b; b.bar = bar; b.x = xb_xcc_id(); b.st = st;
    if (threadIdx.x == 0) (void)xb_add(&bar[XB_XCNT(b.x)], 1u);
    return b;
}
__device__ __forceinline__ void xcd_barrier_complete(unsigned* bar, unsigned x, unsigned& nloc, unsigned& nx) {
    const unsigned G = gridDim.x * gridDim.y * gridDim.z;
    unsigned sum, cnt, mine, sp = 0u;
    for (;;) {
        sum = 0u; cnt = 0u; mine = 0u;
#pragma unroll
        for (unsigned j = 0; j < 16; ++j) { const unsigned c = xb_ld(&bar[XB_XCNT(j)]); sum += c; cnt += (c > 0u) ? 1u : 0u; mine = (j == x) ? c : mine; }
        if (sum == G) break;
        __builtin_amdgcn_s_sleep(1);
        if ((++sp & 255u) == 0u) { if (xb_ld(&bar[XB_TMO])) break; if (sp > XB_SPIN_CAP) { atomicAdd(&bar[XB_TMO], 1u); break; } }
    }
    nloc = mine > 0u ? mine : 1u; nx = cnt > 0u ? cnt : 1u;
}

__device__ __forceinline__ void xcd_barrier(const XcdBarrier& b) {
    asm volatile("s_waitcnt vmcnt(0)" ::: "memory");
    __syncthreads();
    if (threadIdx.x == 0) {
        unsigned* bar = b.bar;
        __builtin_amdgcn_s_waitcnt(0);
        unsigned nloc = b.st[0], nx = b.st[1];
        if (nloc == 0u) { xcd_barrier_complete(bar, b.x, nloc, nx); b.st[0] = nloc; b.st[1] = nx; }
        const unsigned old = xb_add(&bar[XB_XSUB(b.x)], 1u);
        const unsigned gen = old / nloc;
        if (old + 1u == (gen + 1u) * nloc) {
            __builtin_amdgcn_fence(__ATOMIC_RELEASE, "agent");
            asm volatile("s_waitcnt vmcnt(0)" ::: "memory");
            const unsigned og = xb_add(&bar[XB_TOP], 1u);
            const unsigned tg = og / nx;
            if (og + 1u == (tg + 1u) * nx) xb_add(&bar[XB_TOPGEN], 1u);
            else XB_SPIN(xb_ld(&bar[XB_TOPGEN]) == tg, bar);
            __builtin_amdgcn_fence(__ATOMIC_ACQUIRE, "agent");
            xb_add(&bar[XB_XGEN(b.x)], 1u);
            asm volatile("s_waitcnt vmcnt(0)" ::: "memory");
        } else {
            XB_SPIN(xb_ld(&bar[XB_XGEN(b.x)]) == gen, bar);
            __builtin_amdgcn_fence(__ATOMIC_ACQUIRE, "agent");
            asm volatile("s_waitcnt vmcnt(0)" ::: "memory");
        }
    }
    __syncthreads();
}


DI void grid_barrier(unsigned* ctr, unsigned target) {
  asm volatile("s_waitcnt vmcnt(0)" ::: "memory");
  __syncthreads();
  if (threadIdx.x == 0) {
    __builtin_amdgcn_fence(__ATOMIC_RELEASE, "agent");
    asm volatile("s_waitcnt vmcnt(0)" ::: "memory");
    __hip_atomic_fetch_add(ctr, 1u, __ATOMIC_RELAXED, __HIP_MEMORY_SCOPE_AGENT);
    unsigned sp = 0;
    while (__hip_atomic_load(ctr, __ATOMIC_RELAXED, __HIP_MEMORY_SCOPE_AGENT) < target) {
      __builtin_amdgcn_s_sleep(1);
      if (++sp > (1u << 24)) break;
    }
    __builtin_amdgcn_fence(__ATOMIC_ACQUIRE, "agent");
    asm volatile("s_waitcnt vmcnt(0)" ::: "memory");
  }
  __syncthreads();
}

__global__ void __launch_bounds__(NTHR) mk_fwd(Params P) {
  extern __shared__ __attribute__((aligned(16))) unsigned char smem[];
  cg::grid_group grid = cg::this_grid();
  unsigned* bar_ctr = (unsigned*)(P.ws + SM_BAR);
  if (P.ph_lo > 1000) grid.sync();
  XcdBarrier xb;
  {
    volatile LAS unsigned* stw = (volatile LAS unsigned*)(smem + LDS_GEMM);
    if (threadIdx.x == 0) { stw[0] = 0u; stw[1] = 0u; stw[2] = 0u; stw[3] = 0u; }
    __syncthreads();
    if (P.ph_hi - P.ph_lo > 1) xb = xcd_barrier_post(bar_ctr, stw);
    else { xb.bar = bar_ctr; xb.x = 0; xb.st = stw; }
  }
  if ((PHASE_MASK & (1 << 0)) && P.ph_lo <= 0 && 0 < P.ph_hi) {
    if (P.ph_lo < 0) xcd_barrier(xb);
    for (int rep = 0; rep < (((REPEAT_MASK >> 0) & 1) ? 2 : 1); ++rep) phase_prep(P, smem);
    asm volatile("" ::: "memory");
  }
  if ((PHASE_MASK & (1 << 1)) && P.ph_lo <= 1 && 1 < P.ph_hi) {
    if (P.ph_lo < 1) xcd_barrier(xb);
    for (int rep = 0; rep < (((REPEAT_MASK >> 1) & 1) ? 2 : 1); ++rep) phase_inproj(P, smem);
    asm volatile("" ::: "memory");
  }
  if ((PHASE_MASK & (1 << 2)) && P.ph_lo <= 2 && 2 < P.ph_hi) {
    if (P.ph_lo < 2) xcd_barrier(xb);
    phase_queue(P, smem, bar_ctr + 8, (P.ph_hi - P.ph_lo) > 1);
    asm volatile("" ::: "memory");
  }
  if ((PHASE_MASK & (1 << 3)) && P.ph_lo <= 3 && 3 < P.ph_hi && (P.ph_hi - P.ph_lo) <= 1) {
    if (P.ph_lo < 3) xcd_barrier(xb);
    for (int rep = 0; rep < (((REPEAT_MASK >> 3) & 1) ? 2 : 1); ++rep) phase_cmp2(P, smem);
    asm volatile("" ::: "memory");
  }
  if ((PHASE_MASK & (1 << 4)) && P.ph_lo <= 4 && 4 < P.ph_hi) {
    if (P.ph_lo < 4) xcd_barrier(xb);
    phase_nsa(P, smem, bar_ctr + 9, (P.ph_hi - P.ph_lo) > 1);
    asm volatile("" ::: "memory");
  }
  if ((PHASE_MASK & (1 << 5)) && P.ph_lo <= 5 && 5 < P.ph_hi) {
    if (P.ph_lo < 5) xcd_barrier(xb);
    for (int rep = 0; rep < (((REPEAT_MASK >> 5) & 1) ? 2 : 1); ++rep) phase_merge(P, smem);
    asm volatile("" ::: "memory");
  }
  if ((PHASE_MASK & (1 << 6)) && P.ph_lo <= 6 && 6 < P.ph_hi) {
    if (P.ph_lo < 6) xcd_barrier(xb);
    for (int rep = 0; rep < (((REPEAT_MASK >> 6) & 1) ? 2 : 1); ++rep) phase_outproj(P, smem);
    asm volatile("" ::: "memory");
  }
  if ((PHASE_MASK & (1 << 7)) && P.ph_lo <= 7 && 7 < P.ph_hi) {
    if (P.ph_lo < 7) xcd_barrier(xb);
    for (int rep = 0; rep < (((REPEAT_MASK >> 7) & 1) ? 2 : 1); ++rep) phase_ln1(P);
    asm volatile("" ::: "memory");
  }
  if ((PHASE_MASK & (1 << 8)) && P.ph_lo <= 8 && 8 < P.ph_hi) {
    if (P.ph_lo < 8) xcd_barrier(xb);
    for (int rep = 0; rep < (((REPEAT_MASK >> 8) & 1) ? 2 : 1); ++rep) phase_route(P, smem);
    asm volatile("" ::: "memory");
  }
  if ((PHASE_MASK & (1 << 9)) && P.ph_lo <= 9 && 9 < P.ph_hi) {
    if (P.ph_lo < 9) xcd_barrier(xb);
    for (int rep = 0; rep < (((REPEAT_MASK >> 9) & 1) ? 2 : 1); ++rep) phase_gather(P, smem);
    asm volatile("" ::: "memory");
  }
  if ((PHASE_MASK & (1 << 10)) && P.ph_lo <= 10 && 10 < P.ph_hi) {
    if (P.ph_lo < 10) xcd_barrier(xb);
    for (int rep = 0; rep < (((REPEAT_MASK >> 10) & 1) ? 2 : 1); ++rep) phase_final(P, smem, (((REPEAT_MASK >> 10) & 1) != 0) && rep == 0);
    for (int xs = 0; xs < EXTRA_SYNCS; ++xs) xcd_barrier(xb);
    asm volatile("" ::: "memory");
  }
}

static void add_job(Params& p, const float* src, size_t dst_off, int ld, int col0, int ncols, int npad, int K) {
  TJob& j = p.jobs[p.njobs++];
  j.src = src; j.dst = (bf16_t*)(p.ws + dst_off); j.ld = ld; j.col0 = col0; j.ncols = ncols; j.npad = npad; j.K = K; j.tile0 = p.ntiles_t;
  p.ntiles_t += (npad / 64) * (K / 64);
}

extern "C" void kernel_launch(void* const* d_in, const int* in_sizes, int n_in, void* d_out, int out_size, void* d_ws, size_t ws_size, hipStream_t stream) {
  static int grid = 0;
  if (grid == 0) {
    int dev = 0, cus = 0, per_cu = 0;
    hipGetDevice(&dev);
    hipDeviceGetAttribute(&cus, hipDeviceAttributeMultiprocessorCount, dev);
    hipFuncSetAttribute((const void*)mk_fwd, hipFuncAttributeMaxDynamicSharedMemorySize, LDS_BYTES);
    hipOccupancyMaxActiveBlocksPerMultiprocessor(&per_cu, (const void*)mk_fwd, NTHR, LDS_BYTES);
    if (per_cu < 1) { fprintf(stderr, "occupancy query returned %d\n", per_cu); per_cu = 1; }
    grid = cus * per_cu;
    (void)hipGetLastError();
  }
  Params p;
  memset(&p, 0, sizeof(p));
  for (int i = 0; i < 28; ++i) p.in[i] = (const float*)d_in[i];
  p.out = (float*)d_out; p.ws = (unsigned char*)d_ws;
  const float* w_in = p.in[2];
  const size_t e2 = 2;
  add_job(p, w_in, WS_WINR + e2 * 0 * 1024, 4888, 0, 512, 512, 1024);
  add_job(p, w_in, WS_WINR + e2 * 512 * 1024, 4888, 512, 128, 128, 1024);
  add_job(p, w_in, WS_WINR + e2 * 640 * 1024, 4888, 768, 128, 128, 1024);
  add_job(p, w_in, WS_WINR + e2 * 768 * 1024, 4888, 1024, 128, 128, 1024);
  add_job(p, w_in, WS_WINR + e2 * 896 * 1024, 4888, 640, 128, 128, 1024);
  add_job(p, w_in, WS_WINR + e2 * 1024 * 1024, 4888, 1304, 512, 512, 1024);
  add_job(p, w_in, WS_WINR + e2 * 1536 * 1024, 4888, 1816, 512, 512, 1024);
  add_job(p, w_in, WS_WINR + e2 * 2048 * 1024, 4888, 1280, 24, 128, 1024);
  add_job(p, w_in, WS_WINR + e2 * 2176 * 1024, 4888, 896, 128, 128, 1024);
  add_job(p, w_in, WS_WINR + e2 * 2304 * 1024, 4888, 1152, 128, 128, 1024);
  add_job(p, w_in, WS_WINR + e2 * 2432 * 1024, 4888, 2328, 512, 512, 1024);
  add_job(p, p.in[5], WS_CW1K, 256, 0, 256, 256, 2048);
  add_job(p, p.in[7], WS_CW1V, 256, 0, 256, 256, 2048);
  add_job(p, p.in[6], SM_CW2K, 64, 0, 64, 64, 256);
  add_job(p, p.in[8], SM_CW2V, 64, 0, 64, 64, 256);
  p.ntiles_early = p.ntiles_t;
  add_job(p, w_in, WS_WGATE, 4888, 2840, 2048, 2048, 1024);
  add_job(p, p.in[14], WS_WBN, 1024, 0, 1024, 1024, 512);
  add_job(p, p.in[15], WS_WBD, 1024, 0, 1024, 1024, 512);
  add_job(p, p.in[16], WS_WOUT, 1024, 0, 1024, 1024, 1024);
  add_job(p, p.in[19], WS_WQ, 2048, 0, 2048, 2048, 1024);
  add_job(p, p.in[27], WS_WPG, 1024, 0, 1024, 1024, 1024);
  add_job(p, p.in[26], WS_WPP, 1024, 0, 1024, 1024, 256);
#if MULTI_LAUNCH
  for (int ph = 0; ph < NPHASE; ++ph) {
    p.ph_lo = ph; p.ph_hi = ph + 1;
    hipLaunchKernelGGL(mk_fwd, dim3(grid), dim3(NTHR), LDS_BYTES, stream, p);
  }
#else
  p.ph_lo = 0; p.ph_hi = NPHASE;
  (void)hipMemsetAsync((char*)d_ws + SM_BAR, 0, XCD_BAR_WORDS * 4, stream);
  void* args[] = {&p};
  hipError_t e = hipLaunchCooperativeKernel((const void*)mk_fwd, dim3(grid), dim3(NTHR), args, LDS_BYTES, stream);
  if (e != hipSuccess) fprintf(stderr, "cooperative launch failed: %s (grid %d)\n", hipGetErrorString(e), grid);
#endif
}
```

```cpp
#include <hip/hip_runtime.h>
#include <hip/hip_cooperative_groups.h>
#include <cstdio>
#include <cstring>
namespace cg = cooperative_groups;

#ifndef PHASE_MASK
#define PHASE_MASK 0x7ff
#endif
#ifndef REPEAT_MASK
#define REPEAT_MASK 0
#endif
#ifndef PROBE_SEL
#define PROBE_SEL 3
#endif
#ifndef EXTRA_SYNCS
#define EXTRA_SYNCS 0
#endif
#ifndef MULTI_LAUNCH
#define MULTI_LAUNCH 0
#endif

#define DI __device__ __forceinline__
typedef short bf16x8 __attribute__((ext_vector_type(8)));
typedef short s16x4 __attribute__((ext_vector_type(4)));
typedef float f32x16 __attribute__((ext_vector_type(16)));
typedef float f32x4 __attribute__((ext_vector_type(4)));
typedef float f32x2 __attribute__((ext_vector_type(2)));
typedef unsigned u32x4 __attribute__((ext_vector_type(4)));
typedef unsigned u32x2 __attribute__((ext_vector_type(2)));
typedef __bf16 bf2_t __attribute__((ext_vector_type(2)));
typedef unsigned short bf16_t;

#define MFMA(a, b, c) __builtin_amdgcn_mfma_f32_32x32x16_bf16((a), (b), (c), 0, 0, 0)

constexpr int T = 16384, SEQ = 2048, DM = 1024;
constexpr int NTHR = 512;
constexpr int PJ = 2176;
constexpr int NPHASE = 11;
constexpr size_t MiB = 1u << 20;
constexpr size_t WS_WINR = 0, WS_WGATE = 6 * MiB, WS_WBN = 10 * MiB, WS_WBD = 11 * MiB, WS_WOUT = 12 * MiB, WS_WQ = 14 * MiB,
                 WS_WPG = 18 * MiB, WS_WPP = 20 * MiB, WS_CW1K = 21 * MiB, WS_CW1V = 22 * MiB, WS_SMALL = 23 * MiB,
                 WS_XB = 24 * MiB, WS_R = 56 * MiB;
constexpr size_t SM_CW2K = WS_SMALL, SM_CW2V = WS_SMALL + 32768, SM_SK1 = WS_SMALL + 65536, SM_SK2 = WS_SMALL + 98304,
                 SM_CBIAS = WS_SMALL + 131072  , SM_LAM = SM_CBIAS + 32768, SM_BAR = SM_LAM + 1024;
constexpr size_t R_PROJ = WS_R, R_VT = WS_R + 68 * MiB, R_HID = WS_R + 92 * MiB, R_KC = WS_R + 94 * MiB, R_VCT = R_KC + 262144,
                 R_ONSA = WS_R + 95 * MiB, R_ODIFF = WS_R + 111 * MiB;
constexpr size_t R_MERGED = WS_R, R_UB = WS_R + 32 * MiB, R_VB = WS_R + 64 * MiB, R_EID = WS_R + 96 * MiB, R_GW = WS_R + 104 * MiB;
constexpr size_t R_UB8 = 184 * MiB, R_VB8 = 200 * MiB, R_USC = 216 * MiB, R_VSC = R_USC + 65536;
constexpr size_t WS_H1 = 184 * MiB;
constexpr int LDS_GEMM = 147456;
constexpr int LDS_BYTES = LDS_GEMM + 64;
constexpr float LN_ALPHA = 1.189207115f;
constexpr float NEGBIG = -1.0e30f;
constexpr float MINIT = -1.0e9f;

struct TJob { const float* src; bf16_t* dst; int ld, col0, ncols, npad, K, tile0; };
constexpr int MAXJOBS = 24;
struct Params {
  const float* in[28];
  float* out;
  unsigned char* ws;
  TJob jobs[MAXJOBS];
  int njobs, ntiles_t, ntiles_early, pad0, ph_lo, ph_hi;
};

DI unsigned pack2(float a, float b) { f32x2 v = {a, b}; return __builtin_bit_cast(unsigned, __builtin_convertvector(v, bf2_t)); }
DI bf16_t f2bf(float a) { return (bf16_t)(pack2(a, 0.f) & 0xffffu); }
DI float sigmoidf_(float x) { return __builtin_amdgcn_rcpf(1.f + __builtin_amdgcn_exp2f(-1.44269504f * x)); }
DI float geluf_(float x) { return 0.5f * x * (1.f + erff(x * 0.70710678118f)); }
DI float bflo(unsigned w) { return __uint_as_float(w << 16); }
DI float bfhi(unsigned w) { return __uint_as_float(w & 0xffff0000u); }
DI int crow_(int i, int h) { return (i & 3) + 8 * (i >> 2) + 4 * h; }
DI u32x4 cvt8(f32x4 a, f32x4 b) { u32x4 r; r[0] = pack2(a[0], a[1]); r[1] = pack2(a[2], a[3]); r[2] = pack2(b[0], b[1]); r[3] = pack2(b[2], b[3]); return r; }
DI f32x16 zero16() { f32x16 z; for (int i = 0; i < 16; ++i) z[i] = 0.f; return z; }


namespace pg8 {
#define PG8_LAS __attribute__((address_space(3)))
typedef unsigned short bf16_t;
typedef short bf16x8 __attribute__((ext_vector_type(8)));
typedef float f32x4 __attribute__((ext_vector_type(4)));
typedef unsigned u32x4 __attribute__((ext_vector_type(4)));
constexpr int BM = 256, BK = 64, HALF = 128, HTB = HALF * BK * 2  , STAGE_BYTES = 8 * HTB, NXCD = 8, WGM = 8;

__host__ __device__ __forceinline__ int lds_byte(int r, int c) { const int st = (r >> 4) * 2 + (c >> 5), rr = r & 15, cc = c & 31, ob = rr * 64 + cc * 2; return st * 1024 + (ob ^ (((ob >> 9) & 1) << 5)); }
__host__ __device__ __forceinline__ void stage_rc(int b, int& R, int& C) { const int st = b / 1024, sb = b % 1024, swz = sb ^ (((sb >> 9) & 1) << 5); R = (st >> 1) * 16 + swz / 64; C = (st & 1) * 32 + (swz % 64) / 2; }
__host__ __device__ __forceinline__ int perm32(int rho) { const int n = rho >> 4, i = rho & 15; return 8 * (i >> 2) + 4 * n + (i & 3); }

struct Unit { int pm, pn; };
struct Gemm { const bf16_t* A; const bf16_t* Bt; int M, N, K; };

struct StaticOrder {
    int nM, nN, nwg, G, c;
    __host__ __device__ void init(int M, int N, int G_, int c_) { nM = M / BM; nN = N / BM; nwg = nM * nN; G = G_; c = c_; }
    __host__ __device__ bool next(int i, Unit& u) const {
        const long L = (long)i * G + c; if (L >= nwg) return false;
        int wgid = (int)L; { const int q = nwg / NXCD, r = nwg % NXCD, xcd = wgid % NXCD, off = wgid / NXCD; wgid = (xcd < r ? xcd * (q + 1) : r * (q + 1) + (xcd - r) * q) + off; }
        const int nig = WGM * nN, gid = wgid / nig, fm = gid * WGM, gsz = (nM - fm) < WGM ? (nM - fm) : WGM;
        u.pm = fm + ((wgid % nig) % gsz); u.pn = (wgid % nig) / gsz; return true;
    }
    __device__ __forceinline__ void a_ready(const Unit&) const {}
    __device__ __forceinline__ void done(const Unit&) const {}
};
struct CountedOrder : StaticOrder {
    const unsigned* ready; unsigned need; unsigned* tmo;
    __device__ __forceinline__ void a_ready(const Unit& u) const {
        if (threadIdx.x < 64) {
            const unsigned long long t0 = __builtin_amdgcn_s_memrealtime(); unsigned polls = 0;
            while ((unsigned)__builtin_amdgcn_readfirstlane(__hip_atomic_load(ready + 64 * u.pm, __ATOMIC_RELAXED, __HIP_MEMORY_SCOPE_AGENT)) < need) {
                if ((++polls & 255u) == 0u && __builtin_amdgcn_readfirstlane(__hip_atomic_load(tmo, __ATOMIC_RELAXED, __HIP_MEMORY_SCOPE_AGENT)) != 0u) break;
                if (__builtin_amdgcn_s_memrealtime() - t0 > 2000000ull) {
                    if (threadIdx.x == 0) { unsigned expect = 0u; __hip_atomic_compare_exchange_strong(tmo + 1, &expect, 0x600u | (unsigned)(u.pm & 0xff), __ATOMIC_RELAXED, __ATOMIC_RELAXED, __HIP_MEMORY_SCOPE_AGENT); __hip_atomic_store(tmo, 1u, __ATOMIC_RELAXED, __HIP_MEMORY_SCOPE_AGENT); }
                    break; }
                __builtin_amdgcn_s_sleep(2); }
            __builtin_amdgcn_fence(__ATOMIC_ACQUIRE, "agent");
            asm volatile("s_waitcnt vmcnt(0)" ::: "memory");
        }
#if !defined(BROKEN_HOOK_NO_BARRIER)
        asm volatile("" ::: "memory"); __builtin_amdgcn_s_barrier(); asm volatile("" ::: "memory");
#endif
    }
};

__device__ __forceinline__ unsigned cvt_pk_bf16(float lo, float hi) { unsigned r; asm volatile("v_cvt_pk_bf16_f32 %0, %1, %2" : "=v"(r) : "v"(lo), "v"(hi)); return r; }
typedef float f32x2 __attribute__((ext_vector_type(2)));
__device__ __forceinline__ f32x2 gelu_pk(f32x2 v) {
    const f32x2 av = __builtin_elementwise_abs(v), d = av * 0.2316418882f + 1.0f;
    f32x2 t; t.x = __builtin_amdgcn_rcpf(d.x); t.y = __builtin_amdgcn_rcpf(d.y);
    f32x2 q = t * 0.5307027145f + (-0.7265760135f); q = q * t + 0.7107068705f; q = q * t + (-0.142248368f); q = q * t + 0.127414796f; q = q * t;
    const f32x2 s = (v * v) * (-0.72134752044f);
    f32x2 e; e.x = __builtin_amdgcn_exp2f(s.x); e.y = __builtin_amdgcn_exp2f(s.y);
    const f32x2 m = v * (q * e), r = v - m;
    f32x2 o; o.x = v.x < 0.f ? m.x : r.x; o.y = v.y < 0.f ? m.y : r.y; return o;
}

struct EpiF32 {
    static constexpr bool PERM = false, AFTER_DRAIN = false;
    float* C; int ldc; const float* bias;
    __device__ __forceinline__ void operator()(const f32x4 (&acc)[2][2][4][2], const Unit& u, int wr, int wc, int fr, int fq) const {
        const int row0 = u.pm * BM + wr * 64 + fr, col0 = u.pn * BM + wc * 32 + 4 * fq;
        f32x4 bv[2][2];
#pragma unroll
        for (int bj = 0; bj < 2; ++bj)
#pragma unroll
            for (int n = 0; n < 2; ++n) bv[bj][n] = bias ? *(const f32x4*)(bias + col0 + bj * HALF + n * 16) : (f32x4){0.f, 0.f, 0.f, 0.f};
#pragma unroll
        for (int ai = 0; ai < 2; ++ai)
#pragma unroll
            for (int m = 0; m < 4; ++m) { float* rowp = C + (size_t)(row0 + ai * HALF + m * 16) * ldc + col0;
#pragma unroll
                for (int bj = 0; bj < 2; ++bj)
#pragma unroll
                    for (int n = 0; n < 2; ++n) *(f32x4*)(rowp + bj * HALF + n * 16) = acc[ai][bj][m][n] + bv[bj][n]; }
    }
};
template <int ACT  > struct EpiBf16 {
    static constexpr bool PERM = true, AFTER_DRAIN = false;
    bf16_t* O; int ldc; const float* bias; int split_cols; size_t split_stride;
    __device__ __forceinline__ void operator()(const f32x4 (&acc)[2][2][4][2], const Unit& u, int wr, int wc, int fr, int fq) const {
        const int row0 = u.pm * BM + wr * 64 + fr; int colt = u.pn * BM; bf16_t* base = O;
        if (split_cols) { const int t = colt / split_cols; base += (size_t)t * split_stride; colt -= t * split_cols; }
        const int col0 = colt + wc * 32 + 8 * fq, bcol0 = u.pn * BM + wc * 32 + 8 * fq;
        f32x4 bv[2][2];
#pragma unroll
        for (int bj = 0; bj < 2; ++bj)
#pragma unroll
            for (int n = 0; n < 2; ++n) bv[bj][n] = bias ? *(const f32x4*)(bias + bcol0 + bj * HALF + 4 * n) : (f32x4){0.f, 0.f, 0.f, 0.f};
#pragma unroll
        for (int ai = 0; ai < 2; ++ai)
#pragma unroll
            for (int m = 0; m < 4; ++m) { bf16_t* rowp = base + (size_t)(row0 + ai * HALF + m * 16) * ldc + col0;
#pragma unroll
                for (int bj = 0; bj < 2; ++bj) { f32x4 v0 = acc[ai][bj][m][0] + bv[bj][0], v1 = acc[ai][bj][m][1] + bv[bj][1];
                    if (ACT == 1) { f32x2 a = gelu_pk((f32x2){v0[0], v0[1]}), b = gelu_pk((f32x2){v0[2], v0[3]}), c = gelu_pk((f32x2){v1[0], v1[1]}), d = gelu_pk((f32x2){v1[2], v1[3]});
                        v0 = (f32x4){a.x, a.y, b.x, b.y}; v1 = (f32x4){c.x, c.y, d.x, d.y}; }
                    if (ACT == 2) {
#pragma unroll
                        for (int j = 0; j < 4; ++j) { v0[j] = 0.5f * v0[j] * (1.0f + erff(v0[j] * 0.70710678f)); v1[j] = 0.5f * v1[j] * (1.0f + erff(v1[j] * 0.70710678f)); } }
                    u32x4 w; w.x = cvt_pk_bf16(v0[0], v0[1]); w.y = cvt_pk_bf16(v0[2], v0[3]); w.z = cvt_pk_bf16(v1[0], v1[1]); w.w = cvt_pk_bf16(v1[2], v1[3]);
                    *(u32x4*)(rowp + bj * HALF) = w; } }
    }
};

struct PanelStats {
    unsigned* xbuf;
    unsigned* cnt;
    unsigned* tmo;
    int ntn; float eps;
    unsigned code;
    __device__ __forceinline__ bool run(const f32x4 (&v)[2][2][4][2], const Unit& u, int wr, int wc, int fr, int fq, PG8_LAS unsigned char* lds, int wid, int lane) const {
        typedef float f32x2v __attribute__((ext_vector_type(2)));
        PG8_LAS f32x2v* P = (PG8_LAS f32x2v*)lds;
        PG8_LAS f32x2v* S = (PG8_LAS f32x2v*)(lds + 8192);
        PG8_LAS unsigned* flag = (PG8_LAS unsigned*)(lds + 8192 + 2048);
#pragma unroll
        for (int ai = 0; ai < 2; ++ai)
#pragma unroll
            for (int m = 0; m < 4; ++m) {
                float s = 0.f;
#pragma unroll
                for (int bj = 0; bj < 2; ++bj)
#pragma unroll
                    for (int n = 0; n < 2; ++n) { const f32x4 x = v[ai][bj][m][n]; s += (x[0] + x[1]) + (x[2] + x[3]); }
                s += __shfl_xor(s, 16); s += __shfl_xor(s, 32);
                const float mw = s * (1.0f / 64.0f); float q = 0.f;
#pragma unroll
                for (int bj = 0; bj < 2; ++bj)
#pragma unroll
                    for (int n = 0; n < 2; ++n) { const f32x4 d = v[ai][bj][m][n] - mw; q += (d[0] * d[0] + d[1] * d[1]) + (d[2] * d[2] + d[3] * d[3]); }
                q += __shfl_xor(q, 16); q += __shfl_xor(q, 32);
                if (fq == 0) P[(ai * HALF + wr * 64 + m * 16 + fr) * 4 + wc] = (f32x2v){mw, q};
            }
        asm volatile("s_waitcnt lgkmcnt(0)" ::: "memory"); __builtin_amdgcn_s_barrier(); asm volatile("" ::: "memory");
#if defined(BROKEN_NO_WAIT)
        if (blockIdx.x >= 64) { const long long t0 = clock64(); while (clock64() - t0 < 60000) __builtin_amdgcn_s_sleep(8); }
#endif
        const int row = wid * 32 + (lane & 31);
        if (lane < 32) {
            const f32x2v a = P[row * 4 + 0], b = P[row * 4 + 1], c = P[row * 4 + 2], d = P[row * 4 + 3];
            const float mt = (a.x + b.x + c.x + d.x) * 0.25f;
            const float da = a.x - mt, db = b.x - mt, dc = c.x - mt, dd = d.x - mt;
            const float m2 = (a.y + b.y) + (c.y + d.y) + 64.0f * ((da * da + db * db) + (dc * dc + dd * dd));
            unsigned long long* slot = (unsigned long long*)xbuf + ((size_t)(u.pm * BM + row) * 4 + u.pn);
            __hip_atomic_store(slot, ((unsigned long long)__float_as_uint(m2) << 32) | __float_as_uint(mt), __ATOMIC_RELAXED, __HIP_MEMORY_SCOPE_AGENT);
        }
        asm volatile("s_waitcnt vmcnt(0)" ::: "memory");
        if (lane == 0) __hip_atomic_fetch_add(cnt + 64 * u.pm, 1u, __ATOMIC_RELAXED, __HIP_MEMORY_SCOPE_AGENT);
        if (wid == 0) {
            bool dead = false; const unsigned long long t0 = __builtin_amdgcn_s_memrealtime(); const unsigned want = 8u * (unsigned)ntn;
            for (;;) {
#if defined(BROKEN_NO_WAIT)
                break;
#endif
                if ((unsigned)__builtin_amdgcn_readfirstlane(__hip_atomic_load(cnt + 64 * u.pm, __ATOMIC_RELAXED, __HIP_MEMORY_SCOPE_AGENT)) >= want) break;
                if (__builtin_amdgcn_s_memrealtime() - t0 > 2000000ull) {
                    if (lane == 0) { unsigned expect = 0u; __hip_atomic_compare_exchange_strong(tmo + 1, &expect, code | (unsigned)(u.pm & 0xff), __ATOMIC_RELAXED, __ATOMIC_RELAXED, __HIP_MEMORY_SCOPE_AGENT);
                                     __hip_atomic_store(tmo, 1u, __ATOMIC_RELAXED, __HIP_MEMORY_SCOPE_AGENT); }
                    dead = true; break; }
                __builtin_amdgcn_s_sleep(2);
            }
            __builtin_amdgcn_fence(__ATOMIC_ACQUIRE, "agent");
            if (lane == 0) flag[0] = dead ? 1u : 0u;
        }
        asm volatile("s_waitcnt vmcnt(0) lgkmcnt(0)" ::: "memory"); __builtin_amdgcn_s_barrier(); asm volatile("" ::: "memory");
        const bool bad = flag[0] != 0u;
        if (lane < 32) {
            const unsigned long long* slot = (const unsigned long long*)xbuf + (size_t)(u.pm * BM + row) * 4; float mt[4], m2[4]; float ms = 0.f;
#pragma unroll
            for (int t = 0; t < 4; ++t) { if (t < ntn) { const unsigned long long w = __hip_atomic_load(slot + t, __ATOMIC_RELAXED, __HIP_MEMORY_SCOPE_AGENT); mt[t] = __uint_as_float((unsigned)w); m2[t] = __uint_as_float((unsigned)(w >> 32)); } else { mt[t] = 0.f; m2[t] = 0.f; } ms += mt[t]; }
            const float mean = ms / (float)ntn; float q = 0.f;
#pragma unroll
            for (int t = 0; t < 4; ++t) if (t < ntn) { const float dm = mt[t] - mean; q += m2[t] + 256.0f * dm * dm; }
            S[row] = (f32x2v){mean, 1.0f / sqrtf(q / (256.0f * (float)ntn) + eps)};
        }
        asm volatile("s_waitcnt lgkmcnt(0)" ::: "memory"); __builtin_amdgcn_s_barrier(); asm volatile("" ::: "memory");
        return bad;
    }
};
struct EpiLnRes {
    static constexpr bool PERM = false, AFTER_DRAIN = true;
    const float* base; float* out; int ldc; const float* bias; PanelStats st; unsigned poison;
    __device__ __forceinline__ void refuse(size_t i0, size_t stride, int M, int N) const { const float q = __builtin_nanf(""); for (size_t i = i0; i < (size_t)M * N; i += stride) out[(i / N) * ldc + i % N] = q;
        if (i0 == 0) { unsigned expect = 0u; __hip_atomic_compare_exchange_strong(st.tmo + 1, &expect, 0x7f0u, __ATOMIC_RELAXED, __ATOMIC_RELAXED, __HIP_MEMORY_SCOPE_AGENT); __hip_atomic_store(st.tmo, 1u, __ATOMIC_RELAXED, __HIP_MEMORY_SCOPE_AGENT); } }
    __device__ __forceinline__ void fused(f32x4 (&acc)[2][2][4][2], const Unit& u, int wr, int wc, int fr, int fq, PG8_LAS unsigned char* lds, int wid, int lane) const {
        typedef float f32x2v __attribute__((ext_vector_type(2)));
        const PG8_LAS f32x2v* S = (const PG8_LAS f32x2v*)(lds + 8192);
        const int col0 = u.pn * BM + wc * 32 + 4 * fq;
#pragma unroll
        for (int bj = 0; bj < 2; ++bj)
#pragma unroll
            for (int n = 0; n < 2; ++n) { const f32x4 bv = bias ? *(const f32x4*)(bias + col0 + bj * HALF + n * 16) : (f32x4){0.f, 0.f, 0.f, 0.f};
#pragma unroll
                for (int ai = 0; ai < 2; ++ai)
#pragma unroll
                    for (int m = 0; m < 4; ++m) acc[ai][bj][m][n] += bv; }
        const bool bad = st.run(acc, u, wr, wc, fr, fq, lds, wid, lane) || poison != 0u;
        const float qnan = __builtin_nanf("");
#pragma unroll
        for (int ai = 0; ai < 2; ++ai)
#pragma unroll
            for (int m = 0; m < 4; ++m) { const int r = ai * HALF + wr * 64 + m * 16 + fr; const f32x2v sr = S[r]; const size_t off = (size_t)(u.pm * BM + r) * ldc + col0;
#pragma unroll
                for (int bj = 0; bj < 2; ++bj)
#pragma unroll
                    for (int n = 0; n < 2; ++n) { const f32x4 bs = *(const f32x4*)(base + off + bj * HALF + n * 16); f32x4 o = bs + (acc[ai][bj][m][n] - sr.x) * sr.y;
                        if (bad) o = (f32x4){qnan, qnan, qnan, qnan}; *(f32x4*)(out + off + bj * HALF + n * 16) = o; }
                asm volatile("" ::: "memory"); }
    }
};
struct EpiLnResLn {
    static constexpr bool PERM = false, AFTER_DRAIN = true;
    const float* base; float* out; bf16_t* xn; int ldc; const float* bias; PanelStats st1, st2; unsigned poison;
    __device__ __forceinline__ void refuse(size_t i0, size_t stride, int M, int N) const { const float q = __builtin_nanf(""); for (size_t i = i0; i < (size_t)M * N; i += stride) { const size_t o = (i / N) * ldc + i % N; out[o] = q; xn[o] = (bf16_t)0x7fc0u; }
        if (i0 == 0) { unsigned expect = 0u; __hip_atomic_compare_exchange_strong(st1.tmo + 1, &expect, 0x7f0u, __ATOMIC_RELAXED, __ATOMIC_RELAXED, __HIP_MEMORY_SCOPE_AGENT); __hip_atomic_store(st1.tmo, 1u, __ATOMIC_RELAXED, __HIP_MEMORY_SCOPE_AGENT); } }
    __device__ __forceinline__ void fused(f32x4 (&acc)[2][2][4][2], const Unit& u, int wr, int wc, int fr, int fq, PG8_LAS unsigned char* lds, int wid, int lane) const {
        typedef float f32x2v __attribute__((ext_vector_type(2))); typedef unsigned u32x2v __attribute__((ext_vector_type(2)));
        const PG8_LAS f32x2v* S = (const PG8_LAS f32x2v*)(lds + 8192);
        const int col0 = u.pn * BM + wc * 32 + 4 * fq;
#pragma unroll
        for (int bj = 0; bj < 2; ++bj)
#pragma unroll
            for (int n = 0; n < 2; ++n) { const f32x4 bv = bias ? *(const f32x4*)(bias + col0 + bj * HALF + n * 16) : (f32x4){0.f, 0.f, 0.f, 0.f};
#pragma unroll
                for (int ai = 0; ai < 2; ++ai)
#pragma unroll
                    for (int m = 0; m < 4; ++m) acc[ai][bj][m][n] += bv; }
        bool bad = st1.run(acc, u, wr, wc, fr, fq, lds, wid, lane) || poison != 0u;
        const float qnan = __builtin_nanf("");
#pragma unroll
        for (int ai = 0; ai < 2; ++ai)
#pragma unroll
            for (int m = 0; m < 4; ++m) { const int r = ai * HALF + wr * 64 + m * 16 + fr; const f32x2v sr = S[r]; const size_t off = (size_t)(u.pm * BM + r) * ldc + col0;
#pragma unroll
                for (int bj = 0; bj < 2; ++bj)
#pragma unroll
                    for (int n = 0; n < 2; ++n) { const f32x4 bs = *(const f32x4*)(base + off + bj * HALF + n * 16); acc[ai][bj][m][n] = bs + (acc[ai][bj][m][n] - sr.x) * sr.y; }
                asm volatile("" : "+v"(acc[ai][0][m][0]), "+v"(acc[ai][0][m][1]), "+v"(acc[ai][1][m][0]), "+v"(acc[ai][1][m][1]));
                if (m & 1) asm volatile("" ::: "memory"); }
        const bool bad1 = bad;
        bad = st2.run(acc, u, wr, wc, fr, fq, lds, wid, lane) || bad;
#pragma unroll
        for (int ai = 0; ai < 2; ++ai)
#pragma unroll
            for (int m = 0; m < 4; ++m) { const int r = ai * HALF + wr * 64 + m * 16 + fr; const f32x2v sr = S[r]; const size_t off = (size_t)(u.pm * BM + r) * ldc + col0;
#pragma unroll
                for (int bj = 0; bj < 2; ++bj)
#pragma unroll
                    for (int n = 0; n < 2; ++n) { const f32x4 x1 = acc[ai][bj][m][n]; *(f32x4*)(out + off + bj * HALF + n * 16) = bad1 ? (f32x4){qnan, qnan, qnan, qnan} : x1;
                        const f32x4 o = (x1 - sr.x) * sr.y; u32x2v w; w.x = cvt_pk_bf16(o[0], o[1]); w.y = cvt_pk_bf16(o[2], o[3]);
                        if (bad) { w.x = 0x7fc07fc0u; w.y = 0x7fc07fc0u; } *(u32x2v*)(xn + off + bj * HALF + n * 16) = w; }
                asm volatile("" ::: "memory"); }
    }
};

template <class Epi, class Sched, bool STAMP = false>
__device__ __forceinline__ void gemm_phase(PG8_LAS unsigned char* lds, const Gemm g, const Sched& S, const Epi& E, unsigned long long* stamps) {
    const int tid = threadIdx.x, wid = __builtin_amdgcn_readfirstlane(tid >> 6), lane = tid & 63, wr = wid >> 2, wc = wid & 3, fr = lane & 15, fq = lane >> 4;
    const int K = g.K, nt = K / BK;
    int ts_lo = 0, ts_hi = 0, nts = 0; const unsigned long long rt_entry = STAMP ? (unsigned long long)wall_clock64() : 0ull;
#define PG8_STAMP() do { if (STAMP && wid == 0 && nts < 64) { const unsigned long long _c = (unsigned long long)clock64(); \
        ts_lo = (lane == nts) ? (int)(unsigned)_c : ts_lo; ts_hi = (lane == nts) ? (int)(unsigned)(_c >> 32) : ts_hi; ++nts; } } while (0)
    PG8_STAMP();
    unsigned voffA[2], voffB[2];
#pragma unroll
    for (int i = 0; i < 2; ++i) { int R, C; stage_rc(tid * 16 + i * 8192, R, C); const int Rb = Epi::PERM ? ((R & ~31) + perm32(R & 31)) : R;
        voffA[i] = (unsigned)(R * K + C) * 2u; voffB[i] = (unsigned)(Rb * K + C) * 2u; }
    const size_t kstep = (size_t)(BK * 2);
    const size_t hstep = (size_t)HALF * K * 2;
    const size_t tstep = 2 * hstep;
    const unsigned ldsw = (unsigned)wid * 1024u;
    const int aoff = lds_byte(wr * 64 + fr, fq * 8), boff = lds_byte(wc * 32 + fr, fq * 8);
#define PG8_SA(b, h) (((b) * 2 + (h)) * HTB)
#define PG8_SB(b, h) ((4 + (b) * 2 + (h)) * HTB)
#define PG8_STAGE(bufoff, gbase, voff) do { _Pragma("unroll") for (int _i = 0; _i < 2; ++_i) \
        __builtin_amdgcn_global_load_lds((const unsigned*)((const char*)(gbase) + (voff)[_i]), (PG8_LAS unsigned*)(lds + (bufoff) + ldsw + _i * 8192), 16, 0, 0); } while (0)
#define PG8_LDA(dst, b, h) do { _Pragma("unroll") for (int m = 0; m < 4; ++m) _Pragma("unroll") for (int k = 0; k < 2; ++k) dst[m][k] = *(const PG8_LAS bf16x8*)(lds + PG8_SA(b, h) + aoff + m * 2048 + k * 1024); } while (0)
#define PG8_LDB(dst, b, h) do { _Pragma("unroll") for (int n = 0; n < 2; ++n) _Pragma("unroll") for (int k = 0; k < 2; ++k) dst[n][k] = *(const PG8_LAS bf16x8*)(lds + PG8_SB(b, h) + boff + n * 2048 + k * 1024); } while (0)
#define PG8_MMA(ai, bj, At, Bt) do { __builtin_amdgcn_s_setprio(1); _Pragma("unroll") for (int m = 0; m < 4; ++m) _Pragma("unroll") for (int n = 0; n < 2; ++n) _Pragma("unroll") for (int k = 0; k < 2; ++k) \
        acc[ai][bj][m][n] = __builtin_amdgcn_mfma_f32_16x16x32_bf16(Bt[n][k], At[m][k], acc[ai][bj][m][n], 0, 0, 0); __builtin_amdgcn_s_setprio(0); } while (0)
#define PG8_WAIT_V(n) asm volatile("s_waitcnt vmcnt(" #n ")" ::: "memory")
#define PG8_WAIT_L(n) asm volatile("s_waitcnt lgkmcnt(" #n ")" ::: "memory")
#define PG8_BAR __builtin_amdgcn_s_barrier()
#define PG8_SCHED __builtin_amdgcn_sched_barrier(0)
    Unit cur, nxt; int ui = 0;
    if (!S.next(0, cur)) return;
    f32x4 acc[2][2][4][2];
#pragma unroll
    for (int a = 0; a < 2; ++a)
#pragma unroll
        for (int b = 0; b < 2; ++b)
#pragma unroll
            for (int m = 0; m < 4; ++m)
#pragma unroll
                for (int n = 0; n < 2; ++n) acc[a][b][m][n] = (f32x4){0.f, 0.f, 0.f, 0.f};
    bf16x8 At[4][2], B0[2][2], B1[2][2];
    const char* cA = (const char*)g.A + (size_t)cur.pm * tstep; const char* cB = (const char*)g.Bt + (size_t)cur.pn * tstep;
    S.a_ready(cur);
    PG8_STAGE(PG8_SB(0, 0), cB, voffB); PG8_STAGE(PG8_SA(0, 0), cA, voffA); PG8_STAGE(PG8_SB(0, 1), cB + hstep, voffB); PG8_STAGE(PG8_SA(0, 1), cA + hstep, voffA);
    if (wr == 1) PG8_BAR;
    PG8_WAIT_V(4); PG8_BAR;
    PG8_STAGE(PG8_SB(1, 0), cB + kstep, voffB); PG8_STAGE(PG8_SA(1, 0), cA + kstep, voffA); PG8_STAGE(PG8_SB(1, 1), cB + hstep + kstep, voffB);
    PG8_WAIT_V(6); PG8_BAR;
    PG8_STAMP();
    for (;;) {
        const bool has_next = S.next(ui + 1, nxt);
        const char* nA = has_next ? (const char*)g.A + (size_t)nxt.pm * tstep : cA; const char* nB = has_next ? (const char*)g.Bt + (size_t)nxt.pn * tstep : cB;
        for (int t = 0; t < nt; t += 2) {
            const bool last = (t == nt - 2);
            const char* a1 = cA + (size_t)(t + 1) * kstep;
            const char* a2 = last ? nA : cA + (size_t)(t + 2) * kstep; const char* b2 = last ? nB : cB + (size_t)(t + 2) * kstep;
            const char* a3 = a2 + kstep; const char* b3 = b2 + kstep;
            if (last && has_next) S.a_ready(nxt);
            PG8_LDB(B0, 0, 0); PG8_SCHED; PG8_LDA(At, 0, 0); PG8_STAGE(PG8_SA(1, 1), a1 + hstep, voffA);
            PG8_WAIT_L(8); PG8_BAR; PG8_WAIT_L(0); PG8_MMA(0, 0, At, B0); PG8_BAR; PG8_SCHED;
            PG8_LDB(B1, 0, 1); PG8_STAGE(PG8_SB(0, 0), b2, voffB);
            PG8_BAR; PG8_WAIT_L(0); PG8_MMA(0, 1, At, B1); PG8_BAR;
            PG8_LDA(At, 0, 1); PG8_STAGE(PG8_SA(0, 0), a2, voffA);
            PG8_BAR; PG8_WAIT_L(0); PG8_MMA(1, 0, At, B0); PG8_BAR; PG8_SCHED;
            PG8_STAGE(PG8_SB(0, 1), b2 + hstep, voffB);
            PG8_WAIT_V(6); PG8_BAR; PG8_MMA(1, 1, At, B1); PG8_BAR;
            PG8_LDB(B0, 1, 0); PG8_SCHED; PG8_LDA(At, 1, 0); PG8_STAGE(PG8_SA(0, 1), a2 + hstep, voffA);
            PG8_WAIT_L(8); PG8_BAR; PG8_WAIT_L(0); PG8_MMA(0, 0, At, B0); PG8_BAR; PG8_SCHED;
            PG8_LDB(B1, 1, 1); PG8_STAGE(PG8_SB(1, 0), b3, voffB);
            PG8_BAR; PG8_WAIT_L(0); PG8_MMA(0, 1, At, B1); PG8_BAR;
            PG8_LDA(At, 1, 1); PG8_STAGE(PG8_SA(1, 0), a3, voffA);
            PG8_BAR; PG8_WAIT_L(0); PG8_MMA(1, 0, At, B0); PG8_BAR; PG8_SCHED;
            PG8_STAGE(PG8_SB(1, 1), b3 + hstep, voffB);
            PG8_WAIT_V(6); PG8_BAR; PG8_MMA(1, 1, At, B1); PG8_BAR;
        }
        PG8_STAMP();
        if constexpr (!Epi::AFTER_DRAIN) { E(acc, cur, wr, wc, fr, fq); S.done(cur); }
        PG8_STAMP();
        if (!has_next) break;
#pragma unroll
        for (int a = 0; a < 2; ++a)
#pragma unroll
            for (int b = 0; b < 2; ++b)
#pragma unroll
                for (int m = 0; m < 4; ++m)
#pragma unroll
                    for (int n = 0; n < 2; ++n) acc[a][b][m][n] = (f32x4){0.f, 0.f, 0.f, 0.f};
        cur = nxt; cA = nA; cB = nB; ++ui;
    }
    PG8_WAIT_V(0);
    if (wr == 0) PG8_BAR;
    PG8_BAR;
    if constexpr (Epi::AFTER_DRAIN) { E.fused(acc, cur, wr, wc, fr, fq, lds, wid, lane); S.done(cur); }
    PG8_STAMP();
    if (STAMP && wid == 0) { stamps[lane] = lane < nts ? (((unsigned long long)(unsigned)ts_hi << 32) | (unsigned)ts_lo) : 0ull;
        if (lane == 62) stamps[62] = rt_entry; if (lane == 63) stamps[63] = (unsigned long long)wall_clock64(); }
#undef PG8_STAMP
#undef PG8_SA
#undef PG8_SB
#undef PG8_STAGE
#undef PG8_LDA
#undef PG8_LDB
#undef PG8_MMA
#undef PG8_WAIT_V
#undef PG8_WAIT_L
#undef PG8_BAR
#undef PG8_SCHED
}
}
struct EpiResF32 {
  static constexpr bool PERM = false, AFTER_DRAIN = false;
  float* C; const float* X;
  __device__ __forceinline__ void operator()(const pg8::f32x4 (&acc)[2][2][4][2], const pg8::Unit& u, int wr, int wc, int fr, int fq) const {
    const int row0 = u.pm * 256 + wr * 64 + fr, col0 = u.pn * 256 + wc * 32 + 4 * fq;
#pragma unroll
    for (int ai = 0; ai < 2; ++ai)
#pragma unroll
      for (int m = 0; m < 4; ++m) {
        const size_t ro = (size_t)(row0 + ai * 128 + m * 16) * 1024 + col0;
#pragma unroll
        for (int bj = 0; bj < 2; ++bj)
#pragma unroll
          for (int n = 0; n < 2; ++n) {
            const size_t o = ro + bj * 128 + n * 16;
            const pg8::f32x4 xv = *(const pg8::f32x4*)(X + o);
            *(pg8::f32x4*)(C + o) = xv * 1.189207115f + acc[ai][bj][m][n];
          }
      }
  }
};

struct EpiInProj {
  static constexpr bool PERM = true, AFTER_DRAIN = false;
  unsigned short* proj; unsigned short* vT;
  __device__ __forceinline__ void operator()(const pg8::f32x4 (&acc)[2][2][4][2], const pg8::Unit& u, int wr, int wc, int fr, int fq) const {
    const int row0 = u.pm * 256 + wr * 64 + fr;
#pragma unroll
    for (int bj = 0; bj < 2; ++bj) {
      const int seg = u.pn * 2 + bj;
      const int c0 = u.pn * 256 + bj * 128 + wc * 32 + 8 * fq;
      if (seg < 17) {
        const float sc = (seg < 4 || (seg >= 8 && seg < 12)) ? 0.125f : 1.f;
        const bool sg = (seg == 16);
#pragma unroll
        for (int ai = 0; ai < 2; ++ai)
#pragma unroll
          for (int m = 0; m < 4; ++m) {
            pg8::f32x4 v0 = acc[ai][bj][m][0], v1 = acc[ai][bj][m][1];
            if (sg) {
#pragma unroll
              for (int j = 0; j < 4; ++j) { v0[j] = sigmoidf_(v0[j]); v1[j] = sigmoidf_(v1[j]); }
            } else { v0 *= sc; v1 *= sc; }
            pg8::u32x4 wv; wv.x = pack2(v0[0], v0[1]); wv.y = pack2(v0[2], v0[3]); wv.z = pack2(v1[0], v1[1]); wv.w = pack2(v1[2], v1[3]);
            *(pg8::u32x4*)(proj + (size_t)(row0 + ai * 128 + m * 16) * PJ + c0) = wv;
          }
      } else if (seg < 23) {
#pragma unroll
        for (int ai = 0; ai < 2; ++ai)
#pragma unroll
          for (int m = 0; m < 4; ++m) {
            const int r = row0 + ai * 128 + m * 16, b = r >> 11, sq = r & 2047;
            unsigned short* d = vT + ((size_t)(b * 768 + c0 - 2176) * SEQ + sq);
#pragma unroll
            for (int j = 0; j < 4; ++j) { d[(size_t)j * SEQ] = f2bf(acc[ai][bj][m][0][j]); d[(size_t)(4 + j) * SEQ] = f2bf(acc[ai][bj][m][1][j]); }
          }
      }
    }
  }
};

template <int TM, int TN, bool DEEP = true, class AL, class BL>
DI void gemm_kloop(f32x16 (&acc)[TM][TN], const int nk, AL aload, BL bload, unsigned char* smem) {
  constexpr int BM = 128 * TM, BN = 64 * TN;
  constexpr int STAGE = (BM + BN) * 144;
  const int tid = threadIdx.x, lane = tid & 63, w = tid >> 6, wr = w >> 1, wc = w & 1, l32 = lane & 31, h = lane >> 5;
  u32x4 ra0[2 * TM], rb0[TN], ra1[2 * TM], rb1[TN];
#define GLOAD(RA, RB, KT) { _Pragma("unroll") for (int i = 0; i < 2 * TM; ++i) { int c = tid + i * NTHR; RA[i] = aload(c >> 3, (c & 7) * 8, (KT)); } \
                            _Pragma("unroll") for (int i = 0; i < TN; ++i) { int c = tid + i * NTHR; RB[i] = bload(c >> 3, (c & 7) * 8, (KT)); } }
#define LSTORE(RA, RB, ST) { unsigned char* dA_ = smem + (ST) * STAGE; \
                            _Pragma("unroll") for (int i = 0; i < 2 * TM; ++i) { int c = tid + i * NTHR; *(u32x4*)(dA_ + (c >> 3) * 144 + (c & 7) * 16) = RA[i]; } \
                            _Pragma("unroll") for (int i = 0; i < TN; ++i) { int c = tid + i * NTHR; *(u32x4*)(dA_ + BM * 144 + (c >> 3) * 144 + (c & 7) * 16) = RB[i]; } }
#define COMPUTE(ST) { const unsigned char* sA = smem + (ST) * STAGE; const unsigned char* sB = sA + BM * 144; \
    _Pragma("unroll") for (int ks = 0; ks < 4; ++ks) { bf16x8 a[TM], b[TN]; \
      _Pragma("unroll") for (int tm = 0; tm < TM; ++tm) a[tm] = *(const bf16x8*)(sA + (wr * TM * 32 + tm * 32 + l32) * 144 + (ks * 2 + h) * 16); \
      _Pragma("unroll") for (int tn = 0; tn < TN; ++tn) b[tn] = *(const bf16x8*)(sB + (wc * TN * 32 + tn * 32 + l32) * 144 + (ks * 2 + h) * 16); \
      _Pragma("unroll") for (int tm = 0; tm < TM; ++tm) _Pragma("unroll") for (int tn = 0; tn < TN; ++tn) acc[tm][tn] = MFMA(a[tm], b[tn], acc[tm][tn]); } }
  if (!DEEP) {
    GLOAD(ra0, rb0, 0);
    __syncthreads();
    LSTORE(ra0, rb0, 0);
    __syncthreads();
    for (int kt = 0; kt < nk; ++kt) {
      const int cur = kt & 1;
      if (kt + 1 < nk) GLOAD(ra0, rb0, kt + 1);
      COMPUTE(cur);
      if (kt + 1 < nk) LSTORE(ra0, rb0, cur ^ 1);
      __syncthreads();
    }
    return;
  }
  GLOAD(ra0, rb0, 0);
  if (nk > 1) GLOAD(ra1, rb1, 1);
  __syncthreads();
  LSTORE(ra0, rb0, 0);
  __syncthreads();
  for (int kt = 0; kt < nk; kt += 2) {
    if (kt + 2 < nk) GLOAD(ra0, rb0, kt + 2);
    COMPUTE(0);
    if (kt + 1 < nk) LSTORE(ra1, rb1, 1);
    __syncthreads();
    if (kt + 1 >= nk) break;
    if (kt + 3 < nk) GLOAD(ra1, rb1, kt + 3);
    COMPUTE(1);
    if (kt + 2 < nk) LSTORE(ra0, rb0, 0);
    __syncthreads();
  }
#undef GLOAD
#undef LSTORE
#undef COMPUTE
}
template <int TM, int TN, class F>
DI void gemm_epi(f32x16 (&acc)[TM][TN], F f) {
  const int tid = threadIdx.x, lane = tid & 63, w = tid >> 6, wr = w >> 1, wc = w & 1, l32 = lane & 31, h = lane >> 5;
#pragma unroll
  for (int tm = 0; tm < TM; ++tm)
#pragma unroll
    for (int tn = 0; tn < TN; ++tn)
#pragma unroll
      for (int g = 0; g < 4; ++g)
        f(wr * TM * 32 + tm * 32 + 8 * g + 4 * h, wc * TN * 32 + tn * 32 + l32, acc[tm][tn][4 * g], acc[tm][tn][4 * g + 1], acc[tm][tn][4 * g + 2], acc[tm][tn][4 * g + 3]);
}
template <int TM, int TN, class F>
DI void gemm_epi_rows(f32x16 (&acc)[TM][TN], unsigned char* smem, F f) {
  const int tid = threadIdx.x, lane = tid & 63, w = tid >> 6, wr = w >> 1, wc = w & 1, l32 = lane & 31, h = lane >> 5;
  constexpr int RS = TN * 32 + 4;
  float* st = (float*)smem + w * (32 * RS);
#pragma unroll
  for (int tm = 0; tm < TM; ++tm) {
#pragma unroll
    for (int tn = 0; tn < TN; ++tn)
#pragma unroll
      for (int i = 0; i < 16; ++i) st[crow_(i, h) * RS + tn * 32 + l32] = acc[tm][tn][i];
    __builtin_amdgcn_s_waitcnt(0xc07f);
    constexpr int C4 = TN * 8;
#pragma unroll
    for (int i = 0; i < (32 * C4) / 64; ++i) {
      const int idx = i * 64 + lane, row = idx / C4, c4 = idx % C4;
      const f32x4 v = *(const f32x4*)(st + row * RS + c4 * 4);
      f(wr * TM * 32 + tm * 32 + row, wc * TN * 32 + c4 * 4, v);
    }
    __builtin_amdgcn_s_waitcnt(0xc07f);
  }
}
template <int TM, int TN, class F>
DI void gemm_epi_cols(f32x16 (&acc)[TM][TN], unsigned char* smem, F f) {
  const int tid = threadIdx.x, lane = tid & 63, w = tid >> 6, wr = w >> 1, wc = w & 1, l32 = lane & 31, h = lane >> 5;
  constexpr int RS = TN * 32 + 4;
  float* st = (float*)smem + w * (32 * RS);
#pragma unroll
  for (int tm = 0; tm < TM; ++tm) {
#pragma unroll
    for (int tn = 0; tn < TN; ++tn)
#pragma unroll
      for (int i = 0; i < 16; ++i) st[crow_(i, h) * RS + tn * 32 + l32] = acc[tm][tn][i];
    __builtin_amdgcn_s_waitcnt(0xc07f);
#pragma unroll
    for (int i = 0; i < TN * 2; ++i) {
      const int idx = i * 64 + lane, col = idx % (TN * 32), rg = idx / (TN * 32);
      float v[8];
#pragma unroll
      for (int r = 0; r < 8; ++r) v[r] = st[(rg * 8 + r) * RS + col];
      f(wr * TM * 32 + tm * 32 + rg * 8, wc * TN * 32 + col, v);
    }
    __builtin_amdgcn_s_waitcnt(0xc07f);
  }
}
template <int TM, int TN>
DI void zero_acc(f32x16 (&acc)[TM][TN]) {
#pragma unroll
  for (int a = 0; a < TM; ++a)
#pragma unroll
    for (int b = 0; b < TN; ++b) acc[a][b] = zero16();
}
DI u32x4 ldg16(const bf16_t* p) { return *(const u32x4*)p; }

DI void transpose_tile(const Params& P, int tile, unsigned char* smem) {
  const int tid = threadIdx.x;
  float* tl = (float*)smem;
  int j = 0;
  while (j + 1 < P.njobs && P.jobs[j + 1].tile0 <= tile) ++j;
  const float* src = P.jobs[j].src; bf16_t* dst = P.jobs[j].dst;
  const int ld = P.jobs[j].ld, col0 = P.jobs[j].col0, ncols = P.jobs[j].ncols, K = P.jobs[j].K;
  const int lt = tile - P.jobs[j].tile0, nkt = K >> 6, nt = lt / nkt, k0 = (lt - nt * nkt) << 6;
  __syncthreads();
#pragma unroll
  for (int i = 0; i < 8; ++i) {
    int idx = tid + i * NTHR, kk = idx >> 6, nn = idx & 63, n = nt * 64 + nn;
    tl[kk * 65 + nn] = (n < ncols) ? src[(size_t)(k0 + kk) * ld + col0 + n] : 0.f;
  }
  __syncthreads();
#pragma unroll
  for (int i = 0; i < 4; ++i) {
    int idx = tid + i * NTHR, nn = idx >> 5, kp = idx & 31;
    *(unsigned*)(dst + (size_t)(nt * 64 + nn) * K + k0 + kp * 2) = pack2(tl[(kp * 2) * 65 + nn], tl[(kp * 2 + 1) * 65 + nn]);
  }
}
DI void phase_prep(const Params& P, unsigned char* smem) {
  const int tid = threadIdx.x;
  for (int tile = blockIdx.x; tile < P.ntiles_early; tile += gridDim.x) transpose_tile(P, tile, smem);
  {
    const float* x = P.in[0]; bf16_t* xb = (bf16_t*)(P.ws + WS_XB);
    for (size_t i = (size_t)blockIdx.x * NTHR + tid; i < (size_t)T * DM / 8; i += (size_t)gridDim.x * NTHR) {
      f32x4 a = *(const f32x4*)(x + i * 8), b = *(const f32x4*)(x + i * 8 + 4);
      *(u32x4*)(xb + i * 8) = cvt8(a, b);
    }
    for (int i = blockIdx.x * NTHR + tid; i < 2 * 16384 / 8; i += gridDim.x * NTHR) {
      const int which = i >> 11, e = (i & 2047) * 8;
      const float* s = P.in[20 + which] + e;
      *(u32x4*)((bf16_t*)(P.ws + (which ? SM_SK2 : SM_SK1)) + e) = cvt8(*(const f32x4*)s, *(const f32x4*)(s + 4));
    }
  }
  if (blockIdx.x < 16) {
    const int which = tid >> 8, n = tid & 255, kb = blockIdx.x * 128;
    const float* pos = P.in[3 + which]; const float* w1 = P.in[which ? 7 : 5];
    float s = 0.f;
    for (int k = kb; k < kb + 128; ++k) s += pos[k] * w1[(size_t)k * 256 + n];
    ((float*)(P.ws + SM_CBIAS))[blockIdx.x * 512 + tid] = s;
  }
  if (blockIdx.x == 16 && tid == 0) {
    float a = 0.f, b = 0.f;
    for (int i = 0; i < 64; ++i) { a += P.in[9][i] * P.in[10][i]; b += P.in[11][i] * P.in[12][i]; }
    *(float*)(P.ws + SM_LAM) = expf(a) - expf(b) + 0.2f;
  }
}

DI void phase_inproj(const Params& P, unsigned char* smem) {
  pg8::Gemm g{(const pg8::bf16_t*)(P.ws + WS_XB), (const pg8::bf16_t*)(P.ws + WS_WINR), T, 3072, DM};
  pg8::StaticOrder S; S.init(T, 3072, (int)gridDim.x, (int)blockIdx.x);
  EpiInProj E{(unsigned short*)(P.ws + R_PROJ), (unsigned short*)(P.ws + R_VT)};
  pg8::gemm_phase<EpiInProj, pg8::StaticOrder, false>((PG8_LAS unsigned char*)smem, g, S, E, nullptr);
  __syncthreads();
}

DI void cmp1_tile(const Params& P, int tile, unsigned char* smem) {
  const bf16_t* proj = (const bf16_t*)(P.ws + R_PROJ);
  bf16_t* hid = (bf16_t*)(P.ws + R_HID);
  const float* cb = (const float*)(P.ws + SM_CBIAS);
  {
    const int which = tile >> 4, mt = (tile >> 1) & 7, nt = tile & 1;
    const bf16_t* w1 = (const bf16_t*)(P.ws + (which ? WS_CW1V : WS_CW1K));
    const int colbase = which ? 896 : 512;
    f32x16 acc[2][2]; zero_acc(acc);
    gemm_kloop<2, 2>(acc, 32,
      [&](int r, int ko, int kt) {
        const int m = mt * 256 + r, bg = m >> 7, c = min(m & 127, 126), b = bg >> 1, g = bg & 1;
        return ldg16(proj + (size_t)(b * SEQ + c * 16 + kt) * PJ + colbase + g * 64 + ko); },
      [&](int r, int ko, int kt) { return ldg16(w1 + (size_t)(nt * 128 + r) * 2048 + kt * 64 + ko); }, smem);
    gemm_epi_rows<2, 2>(acc, smem, [&](int m, int n, f32x4 v) {
      const int nn = nt * 128 + n;
      f32x4 bias = {0.f, 0.f, 0.f, 0.f};
#pragma unroll
      for (int j = 0; j < 16; ++j) bias += *(const f32x4*)(cb + j * 512 + which * 256 + nn);
      v += bias;
      u32x2 o = {pack2(geluf_(v[0]), geluf_(v[1])), pack2(geluf_(v[2]), geluf_(v[3]))};
      *(u32x2*)(hid + ((size_t)which * 2048 + mt * 256 + m) * 256 + nn) = o;
    });
  }
}
DI void cmp2_tile(const Params& P, int tile, unsigned char* smem) {
  const bf16_t* hid = (const bf16_t*)(P.ws + R_HID);
  bf16_t* kc = (bf16_t*)(P.ws + R_KC);
  bf16_t* vcT = (bf16_t*)(P.ws + R_VCT);
  {
    const int which = tile >> 3, mt = tile & 7;
    const bf16_t* w2 = (const bf16_t*)(P.ws + (which ? SM_CW2V : SM_CW2K));
    f32x16 acc[2][1]; zero_acc(acc);
    gemm_kloop<2, 1>(acc, 4,
      [&](int r, int ko, int kt) { return ldg16(hid + ((size_t)which * 2048 + mt * 256 + r) * 256 + kt * 64 + ko); },
      [&](int r, int ko, int kt) { return ldg16(w2 + (size_t)r * 256 + kt * 64 + ko); }, smem);
    gemm_epi<2, 1>(acc, [&](int m, int n, float v0, float v1, float v2, float v3) {
      const int mm = mt * 256 + m, bg = mm >> 7, c = mm & 127;
      if (which == 0) {
        bf16_t* d = kc + ((size_t)bg * 128 + c) * 64 + n;
        d[0] = f2bf(v0); d[64] = f2bf(v1); d[128] = f2bf(v2); d[192] = f2bf(v3);
      } else {
        u32x2 v = {pack2(v0, v1), pack2(v2, v3)};
        *(u32x2*)(vcT + ((size_t)bg * 64 + n) * 128 + c) = v;
      }
    });
  }
}

DI void phase_cmp2(const Params& P, unsigned char* smem) {
  for (int tile = blockIdx.x; tile < 16; tile += gridDim.x) cmp2_tile(P, tile, smem);
}
DI int crow(int i, int h) { return (i & 3) + 8 * (i >> 2) + 4 * h; }
DI bf16x8 pack8(const f32x16& x, int s) {
  u32x4 p;
  p[0] = pack2(x[8 * s + 0], x[8 * s + 1]); p[1] = pack2(x[8 * s + 2], x[8 * s + 3]);
  p[2] = pack2(x[8 * s + 4], x[8 * s + 5]); p[3] = pack2(x[8 * s + 6], x[8 * s + 7]);
  return __builtin_bit_cast(bf16x8, p);
}
DI void qk64(f32x16* s, const unsigned char* sK, int rstride, const bf16x8 (&q)[4], int l32, int h) {
#pragma unroll
  for (int kt = 0; kt < 2; ++kt) {
    s[kt] = zero16();
#pragma unroll
    for (int ks = 0; ks < 4; ++ks) {
      bf16x8 a = *(const bf16x8*)(sK + (kt * 32 + l32) * rstride + (ks * 2 + h) * 16);
      s[kt] = MFMA(a, q[ks], s[kt]);
    }
  }
}
template <int NDV>
DI void pv64(f32x16 (&o)[NDV], const f32x16* p, const unsigned char* sV, int rstride, int kofs, int l32, int h) {
#pragma unroll
  for (int ks = 0; ks < 4; ++ks) {
    bf16x8 pb = pack8(p[ks >> 1], ks & 1);
#pragma unroll
    for (int dvt = 0; dvt < NDV; ++dvt) {
      const unsigned char* r = sV + (dvt * 32 + l32) * rstride + (kofs + ks * 16 + 4 * h) * 2;
      s16x4 lo = *(const s16x4*)r, hi = *(const s16x4*)(r + 16);
      bf16x8 a = __builtin_shufflevector(lo, hi, 0, 1, 2, 3, 4, 5, 6, 7);
      o[dvt] = MFMA(a, pb, o[dvt]);
    }
  }
}
template <int NDV>
DI void softmax64(f32x16 (&s)[2], float& m, float& l, f32x16 (&o)[NDV], int t, int kbase, float slope2, bool masked, bool sel, int hi, int h) {
  const float c0 = slope2 * (float)(kbase + 4 * h);
  const f32x2 B0 = {0.f, slope2}, B1 = {2.f * slope2, 3.f * slope2};
  const f32x2 L2 = {1.44269504f, 1.44269504f};
#pragma unroll
  for (int kt = 0; kt < 2; ++kt)
#pragma unroll
    for (int g = 0; g < 4; ++g) {
      const float A = fmaf(slope2, (float)(kt * 32 + 8 * g), c0);
      const f32x2 Av = {A, A};
      f32x2 v0 = {s[kt][4 * g], s[kt][4 * g + 1]}, v1 = {s[kt][4 * g + 2], s[kt][4 * g + 3]};
      v0 = __builtin_elementwise_fma(v0, L2, Av + B0);
      v1 = __builtin_elementwise_fma(v1, L2, Av + B1);
      s[kt][4 * g] = v0[0]; s[kt][4 * g + 1] = v0[1]; s[kt][4 * g + 2] = v1[0]; s[kt][4 * g + 3] = v1[1];
    }
  if (masked) {
    const int tr = t - kbase - 4 * h;
    const unsigned hie = sel ? (unsigned)hi : 0u;
#pragma unroll
    for (int kt = 0; kt < 2; ++kt)
#pragma unroll
      for (int i = 0; i < 16; ++i) {
        const int K = kt * 32 + (i & 3) + 8 * (i >> 2);
        s[kt][i] = ((unsigned)(tr - K) < hie) ? s[kt][i] : NEGBIG;
      }
  }
  float mx = NEGBIG;
#pragma unroll
  for (int kt = 0; kt < 2; ++kt)
#pragma unroll
    for (int i = 0; i < 16; i += 2) mx = fmaxf(fmaxf(s[kt][i], s[kt][i + 1]), mx);
  mx = fmaxf(mx, __shfl_xor(mx, 32));
  const bool need = mx > m + 8.f;
  if (__builtin_amdgcn_ballot_w64(need) != 0ull) {
    const float mn = need ? mx : m;
    const float alpha = __builtin_amdgcn_exp2f(m - mn);
    l *= alpha;
#pragma unroll
    for (int d = 0; d < NDV; ++d) o[d] *= alpha;
    m = mn;
  }
  const f32x2 mv = {m, m};
  f32x2 ls2 = {0.f, 0.f};
#pragma unroll
  for (int kt = 0; kt < 2; ++kt)
#pragma unroll
    for (int i = 0; i < 16; i += 2) {
      const f32x2 d = f32x2{s[kt][i], s[kt][i + 1]} - mv;
      const f32x2 e = {__builtin_amdgcn_exp2f(d[0]), __builtin_amdgcn_exp2f(d[1])};
      s[kt][i] = e[0]; s[kt][i + 1] = e[1];
      ls2 += e;
    }
  l += ls2[0] + ls2[1];
}

DI void nsa_item(const Params& P, int item, unsigned char* smem) {
  const int tid = threadIdx.x, lane = tid & 63, w = __builtin_amdgcn_readfirstlane(tid >> 6), l32 = lane & 31, h = lane >> 5;
  const int qb = item & 31, bg = item >> 5, b = bg >> 1, g = bg & 1;
  const int hw = w & 3, qt = w >> 2, head = g * 4 + hw;
  const int q64 = qt * 32 + l32, t = qb * 64 + q64;
  const size_t token = (size_t)b * SEQ + t;
  const float slope = exp2f(-(float)(head + 1));
  const float slope2 = slope * 1.44269504f;
  const bf16_t* proj = (const bf16_t*)(P.ws + R_PROJ);
  const bf16_t* vT = (const bf16_t*)(P.ws + R_VT);
  unsigned char* sK = smem;
  unsigned char* sV = smem + 18432;
  float* imp = (float*)(smem + 36864);
  unsigned* umask = (unsigned*)(smem + 36864 + 8448);

  bf16x8 q[4];
#pragma unroll
  for (int ks = 0; ks < 4; ++ks) q[ks] = *(const bf16x8*)(proj + token * PJ + head * 64 + ks * 16 + h * 8);
  const float g0 = __uint_as_float((unsigned)proj[token * PJ + 2048 + head * 3 + 0] << 16);
  const float g1 = __uint_as_float((unsigned)proj[token * PJ + 2048 + head * 3 + 1] << 16);
  const float g2 = __uint_as_float((unsigned)proj[token * PJ + 2048 + head * 3 + 2] << 16);

  __syncthreads();
  for (int i = tid; i < 64 * 33; i += NTHR) imp[i] = 0.f;
  if (tid == 0) *umask = 0u;
  {
    const bf16_t* kc = (const bf16_t*)(P.ws + R_KC) + (size_t)bg * 128 * 64;
    const bf16_t* vc = (const bf16_t*)(P.ws + R_VCT) + (size_t)bg * 64 * 128;
#pragma unroll
    for (int i = 0; i < 2; ++i) {
      int c = tid + i * NTHR;
      *(u32x4*)(sK + (c >> 3) * 144 + (c & 7) * 16) = ldg16(kc + (c >> 3) * 64 + (c & 7) * 8);
      *(u32x4*)(sV + (c >> 4) * 272 + (c & 15) * 16) = ldg16(vc + (c >> 4) * 128 + (c & 15) * 8);
    }
  }
  __syncthreads();
  f32x16 comb[2];
  {
    f32x16 sc[4];
    qk64(sc, sK, 144, q, l32, h);
    qk64(sc + 2, sK + 64 * 144, 144, q, l32, h);
    float mx = NEGBIG;
#pragma unroll
    for (int kt = 0; kt < 4; ++kt)
#pragma unroll
      for (int i = 0; i < 16; ++i) {
        const int c = kt * 32 + crow(i, h);
        const int dist = t - (c * 16 + 31);
        const float r = (dist >= 0) ? sc[kt][i] - slope * (float)dist : NEGBIG;
        sc[kt][i] = r;
        mx = fmaxf(mx, r);
      }
    mx = fmaxf(mx, __shfl_xor(mx, 32));
    float ls = 0.f;
#pragma unroll
    for (int kt = 0; kt < 4; ++kt)
#pragma unroll
      for (int i = 0; i < 16; ++i) {
        const float r = (sc[kt][i] > -1.0e29f) ? __expf(sc[kt][i] - mx) : 0.f;
        sc[kt][i] = r;
        ls += r;
      }
    ls += __shfl_xor(ls, 32);
    const float inv = 1.f / fmaxf(ls, 1.0e-30f);
#pragma unroll
    for (int kt = 0; kt < 4; ++kt)
#pragma unroll
      for (int gq = 0; gq < 4; ++gq) {
        const float p0 = sc[kt][4 * gq] * inv, p1 = sc[kt][4 * gq + 1] * inv, p2 = sc[kt][4 * gq + 2] * inv, p3 = sc[kt][4 * gq + 3] * inv;
        sc[kt][4 * gq] = p0; sc[kt][4 * gq + 1] = p1; sc[kt][4 * gq + 2] = p2; sc[kt][4 * gq + 3] = p3;
        const int j = 8 * kt + 2 * gq + h;
        const float sp = 0.5f * p3;
        atomicAdd(&imp[q64 * 33 + j], p0 + p1 + p2 + sp);
        atomicAdd(&imp[q64 * 33 + j + 1], sp);
      }
    f32x16 o[2]; o[0] = zero16(); o[1] = zero16();
    pv64<2>(o, sc, sV, 272, 0, l32, h);
    pv64<2>(o, sc + 2, sV, 272, 64, l32, h);
    comb[0] = o[0] * g0; comb[1] = o[1] * g0;
  }
  __syncthreads();
  const int cur = qb;
  unsigned mask = 1u | (1u << cur) | (cur >= 1 ? (1u << (cur - 1)) : 0u);
  {
    float tv[5]; int ti[5];
#pragma unroll
    for (int k = 0; k < 5; ++k) { tv[k] = -1.f; ti[k] = -1; }
    for (int j = 1; j <= cur - 2; ++j) {
      float v = imp[q64 * 33 + j]; int vi = j;
#pragma unroll
      for (int k = 0; k < 5; ++k) {
        const bool gt = v > tv[k];
        const float nv = gt ? tv[k] : v; const int ni = gt ? ti[k] : vi;
        tv[k] = gt ? v : tv[k]; ti[k] = gt ? vi : ti[k];
        v = nv; vi = ni;
      }
    }
#pragma unroll
    for (int k = 0; k < 5; ++k) if (ti[k] >= 0) mask |= (1u << ti[k]);
  }
  {
    unsigned um = mask;
#pragma unroll
    for (int off = 32; off >= 1; off >>= 1) um |= (unsigned)__shfl_xor((int)um, off);
    if (lane == 0) atomicOr(umask, um);
  }
  __syncthreads();
  const unsigned un = *umask;
#pragma unroll 1
  for (int br = 0; br < 2; ++br) {
    const int kcol = (br == 0 ? 640 : 768) + g * 64;
    const int vrow = (br == 0 ? 0 : 128) + g * 64;
    const int j0 = (br == 0) ? 0 : max(0, cur - 8);
    const int hi = (br == 0) ? 0x7fffffff : 512;
    const unsigned upto = (cur >= 31) ? 0xffffffffu : ((2u << cur) - 1u);
    unsigned tmask = (br == 0) ? (un & upto) : (upto & ~((1u << j0) - 1u));
    float m = MINIT, l = 0.f;
    f32x16 o[2]; o[0] = zero16(); o[1] = zero16();
    const int lr = tid >> 3, lpart = tid & 7;
    const bf16_t* kbase = proj + ((size_t)b * SEQ + lr) * PJ + kcol + lpart * 8;
    const bf16_t* vbase = vT + ((size_t)(b * 768 + vrow + lr) * SEQ + lpart * 8);
    u32x4 rk, rv;
    int j = __builtin_ctz(tmask); tmask &= tmask - 1;
    rk = ldg16(kbase + (size_t)j * 64 * PJ); rv = ldg16(vbase + j * 64);
    __syncthreads();
    *(u32x4*)(sK + lr * 144 + lpart * 16) = rk; *(u32x4*)(sK + 9216 + lr * 144 + lpart * 16) = rv;
    __syncthreads();
    int st = 0;
#pragma unroll 1
    while (true) {
      const bool more = (tmask != 0u);
      int jn = 0;
      if (more) { jn = __builtin_ctz(tmask); tmask &= tmask - 1; rk = ldg16(kbase + (size_t)jn * 64 * PJ); rv = ldg16(vbase + jn * 64); }
      const unsigned char* cK = sK + st * 18432;
      f32x16 sc2[2];
      qk64(sc2, cK, 144, q, l32, h);
      const bool sel = (br == 0) ? (((mask >> j) & 1u) != 0u) : true;
      const int tw0 = qb * 64 + qt * 32;
      const bool fast = (br == 0) ? (j < cur && __builtin_amdgcn_ballot_w64(!sel) == 0ull)
                                  : (j * 64 + 63 <= tw0 && j * 64 >= tw0 + 31 - 511);
      softmax64<2>(sc2, m, l, o, t, j * 64, slope2, !fast, sel, hi, h);
      pv64<2>(o, sc2, cK + 9216, 144, 0, l32, h);
      if (!more) break;
      unsigned char* nK = sK + (st ^ 1) * 18432;
      *(u32x4*)(nK + lr * 144 + lpart * 16) = rk; *(u32x4*)(nK + 9216 + lr * 144 + lpart * 16) = rv;
      __syncthreads();
      st ^= 1; j = jn;
    }
    l += __shfl_xor(l, 32);
    const float scl = (br == 0 ? g1 : g2) / fmaxf(l, 1.0e-30f);
    comb[0] += o[0] * scl; comb[1] += o[1] * scl;
  }
  bf16_t* on = (bf16_t*)(P.ws + R_ONSA) + token * 512 + head * 64;
#pragma unroll
  for (int dvt = 0; dvt < 2; ++dvt)
#pragma unroll
    for (int gq = 0; gq < 4; ++gq) {
      u32x2 v = {pack2(comb[dvt][4 * gq], comb[dvt][4 * gq + 1]), pack2(comb[dvt][4 * gq + 2], comb[dvt][4 * gq + 3])};
      *(u32x2*)(on + dvt * 32 + 8 * gq + 4 * h) = v;
    }
}

DI void diff_item(const Params& P, int item, unsigned char* smem) {
  const int tid = threadIdx.x, lane = tid & 63, w = __builtin_amdgcn_readfirstlane(tid >> 6), l32 = lane & 31, h = lane >> 5;
  const int qb = item & 15, bh = item >> 4, b = bh >> 2, head = bh & 3;
  const int map = w >> 2, qt = w & 3;
  const int t = qb * 128 + qt * 32 + l32;
  const size_t token = (size_t)b * SEQ + t;
  const float slope2 = exp2f(-2.f * (float)(head + 1)) * 1.44269504f;
  const bf16_t* proj = (const bf16_t*)(P.ws + R_PROJ);
  const bf16_t* vT = (const bf16_t*)(P.ws + R_VT);
  unsigned char* sK1 = smem; unsigned char* sK2 = smem + 9216; unsigned char* sV = smem + 18432;
  bf16x8 q[4];
#pragma unroll
  for (int ks = 0; ks < 4; ++ks) q[ks] = *(const bf16x8*)(proj + token * PJ + 1024 + map * 256 + head * 64 + ks * 16 + h * 8);
  float m = MINIT, l = 0.f;
  f32x16 o[4];
#pragma unroll
  for (int d = 0; d < 4; ++d) o[d] = zero16();
  const int tmax_w = qb * 128 + qt * 32 + 31;
  const int lr = tid >> 3, lpart = tid & 7;
  const bf16_t* kbase = proj + ((size_t)b * SEQ + lr) * PJ + 1536 + head * 64 + lpart * 8;
  const bf16_t* vbase0 = vT + ((size_t)(b * 768 + 256 + head * 128 + lr) * SEQ + lpart * 8);
  const bf16_t* vbase1 = vbase0 + (size_t)64 * SEQ;
  const int nj = 2 * qb + 2;
#pragma unroll 1
  for (int j = 0; j < nj; ++j) {
    __syncthreads();
    {
      const size_t ko = (size_t)j * 64 * PJ; const int vo = j * 64;
      const u32x4 rk1 = ldg16(kbase + ko), rk2 = ldg16(kbase + ko + 256), rv0 = ldg16(vbase0 + vo), rv1 = ldg16(vbase1 + vo);
      *(u32x4*)(sK1 + lr * 144 + lpart * 16) = rk1; *(u32x4*)(sK2 + lr * 144 + lpart * 16) = rk2;
      *(u32x4*)(sV + lr * 144 + lpart * 16) = rv0; *(u32x4*)(sV + (64 + lr) * 144 + lpart * 16) = rv1;
    }
    __syncthreads();
    if (j * 64 <= tmax_w) {
      f32x16 sc2[2];
      qk64(sc2, map ? sK2 : sK1, 144, q, l32, h);
      softmax64<4>(sc2, m, l, o, t, j * 64, slope2, !(j * 64 + 63 <= tmax_w - 31), true, 0x7fffffff, h);
      pv64<4>(o, sc2, sV, 144, 0, l32, h);
    }
  }
  l += __shfl_xor(l, 32);
  const float inv = 1.f / fmaxf(l, 1.0e-30f);
  __syncthreads();
  float* ex = (float*)smem;
  if (map == 1) {
#pragma unroll
    for (int d = 0; d < 4; ++d)
#pragma unroll
      for (int i = 0; i < 16; ++i) ex[(qt * 64 + d * 16 + i) * 64 + lane] = o[d][i] * inv;
  }
  __syncthreads();
  if (map == 0) {
    const float lam = __uint_as_float(__hip_atomic_load((const unsigned*)(P.ws + SM_LAM), __ATOMIC_RELAXED, __HIP_MEMORY_SCOPE_AGENT));
    float ss = 0.f;
#pragma unroll
    for (int d = 0; d < 4; ++d)
#pragma unroll
      for (int i = 0; i < 16; ++i) {
        const float v = o[d][i] * inv - lam * ex[(qt * 64 + d * 16 + i) * 64 + lane];
        o[d][i] = v; ss += v * v;
      }
    ss += __shfl_xor(ss, 32);
    const float r = rsqrtf(ss * (1.f / 128.f) + 1.0e-5f) * 0.8f;
    const float* ng = P.in[13];
    bf16_t* od = (bf16_t*)(P.ws + R_ODIFF) + token * 512 + head * 128;
#pragma unroll
    for (int d = 0; d < 4; ++d)
#pragma unroll
      for (int gq = 0; gq < 4; ++gq) {
        const int dv = d * 32 + 8 * gq + 4 * h;
        const f32x4 gg = *(const f32x4*)(ng + dv);
        u32x2 v = {pack2(o[d][4 * gq] * r * gg[0], o[d][4 * gq + 1] * r * gg[1]), pack2(o[d][4 * gq + 2] * r * gg[2], o[d][4 * gq + 3] * r * gg[3])};
        *(u32x2*)(od + dv) = v;
      }
  }
}

DI void fp8_conv_item(const Params& P, int item);
#ifndef ATTN_SEL
#define ATTN_SEL 3
#endif
DI void phase_queue(const Params& P, unsigned char* smem, unsigned* qctr, const bool dyn) {
  const int ng = (P.ntiles_t - P.ntiles_early + 7) >> 3;
  const int nm = 512 + ng;
  const int total = 32 + 512 + nm;
  unsigned* done = qctr + 8;
  volatile int* sidx = (volatile int*)(smem + LDS_GEMM + 32);
  int idx = blockIdx.x;
  while (true) {
    if (dyn) {
      __syncthreads();
      if (threadIdx.x == 0) *sidx = (int)__hip_atomic_fetch_add(qctr, 1u, __ATOMIC_RELAXED, __HIP_MEMORY_SCOPE_AGENT);
      __syncthreads();
      idx = *sidx;
    }
    if (idx >= total) break;
    if (idx < 32) {
      cmp1_tile(P, idx, smem);
      if (dyn) {
        asm volatile("s_waitcnt vmcnt(0)" ::: "memory");
        __syncthreads();
        if (threadIdx.x == 0) {
          __builtin_amdgcn_fence(__ATOMIC_RELEASE, "agent");
          asm volatile("s_waitcnt vmcnt(0)" ::: "memory");
          __hip_atomic_fetch_add(&done[(idx >> 4) * 8 + ((idx >> 1) & 7)], 1u, __ATOMIC_RELAXED, __HIP_MEMORY_SCOPE_AGENT);
        }
      }
    } else {
      const int j = idx - 32;
      int kind, it;
      if (j < 1024) { kind = j & 1; it = j >> 1; } else { kind = 1; it = j - 512; }
      if (kind == 0) {
        if (ATTN_SEL & 1) { const int bh = it & 31, qb = 15 - (it >> 5); diff_item(P, bh * 16 + qb, smem); }
      } else if (it < 512) fp8_conv_item(P, it);
      else {
        const int t0 = P.ntiles_early + (it - 512) * 8;
        for (int tt = t0; tt < min(t0 + 8, P.ntiles_t); ++tt) transpose_tile(P, tt, smem);
      }
    }
    if (!dyn) idx += gridDim.x;
  }
  asm volatile("" ::: "memory");
  if (dyn && blockIdx.x < 16) {
    const int ct = blockIdx.x;
    if (threadIdx.x == 0) {
      unsigned sp = 0;
      while (__hip_atomic_load(&done[ct], __ATOMIC_RELAXED, __HIP_MEMORY_SCOPE_AGENT) < 2u) { __builtin_amdgcn_s_sleep(2); if (++sp > (1u << 22)) break; }
      __builtin_amdgcn_fence(__ATOMIC_ACQUIRE, "agent");
      asm volatile("s_waitcnt vmcnt(0)" ::: "memory");
    }
    __syncthreads();
    cmp2_tile(P, ct, smem);
  }
}
DI void phase_nsa(const Params& P, unsigned char* smem, unsigned* qctr, const bool dyn) {
  volatile int* sidx = (volatile int*)(smem + LDS_GEMM + 32);
  int idx = blockIdx.x;
  if (!(ATTN_SEL & 2)) return;
  while (true) {
    if (dyn) {
      __syncthreads();
      if (threadIdx.x == 0) *sidx = (int)__hip_atomic_fetch_add(qctr, 1u, __ATOMIC_RELAXED, __HIP_MEMORY_SCOPE_AGENT);
      __syncthreads();
      idx = *sidx;
    }
    if (idx >= 512) break;
    const int bg = idx & 15, qb = 31 - (idx >> 4);
    nsa_item(P, bg * 32 + qb, smem);
    if (!dyn) idx += gridDim.x;
  }
}

DI void phase_merge(const Params& P, unsigned char* smem) {
  const bf16_t* xb = (const bf16_t*)(P.ws + WS_XB);
  const bf16_t* wg = (const bf16_t*)(P.ws + WS_WGATE);
  const bf16_t* wbn = (const bf16_t*)(P.ws + WS_WBN);
  const bf16_t* wbd = (const bf16_t*)(P.ws + WS_WBD);
  const bf16_t* onsa = (const bf16_t*)(P.ws + R_ONSA);
  const bf16_t* odiff = (const bf16_t*)(P.ws + R_ODIFF);
  bf16_t* merged = (bf16_t*)(P.ws + R_MERGED);
#pragma unroll 1
  for (int tile = blockIdx.x; tile < 64 * 8; tile += gridDim.x) {
    const int mt = tile >> 3, nt = tile & 7, m0 = mt * 256, n0 = nt * 128;
    unsigned resp[2][2][8];
    unsigned gp[2][2][8];
    f32x16 va[2][2];
#pragma unroll
    for (int br = 0; br < 2; ++br) {
      zero_acc(va);
      const bf16_t* wgb = wg + (size_t)br * 1024 * DM;
      gemm_kloop<2, 2, false>(va, 16,
        [&](int r, int ko, int kt) { return ldg16(xb + (size_t)(m0 + r) * DM + kt * 64 + ko); },
        [&](int r, int ko, int kt) { return ldg16(wgb + (size_t)(n0 + r) * DM + kt * 64 + ko); }, smem);
#pragma unroll
      for (int tm = 0; tm < 2; ++tm)
#pragma unroll
        for (int tn = 0; tn < 2; ++tn)
#pragma unroll
          for (int i = 0; i < 8; ++i) gp[tm][tn][i] = pack2(sigmoidf_(va[tm][tn][2 * i]), sigmoidf_(va[tm][tn][2 * i + 1]));
      zero_acc(va);
      const bf16_t* oa = br ? odiff : onsa; const bf16_t* wb = br ? wbd : wbn;
      gemm_kloop<2, 2, false>(va, 8,
        [&](int r, int ko, int kt) { return ldg16(oa + (size_t)(m0 + r) * 512 + kt * 64 + ko); },
        [&](int r, int ko, int kt) { return ldg16(wb + (size_t)(n0 + r) * 512 + kt * 64 + ko); }, smem);
#pragma unroll
      for (int tm = 0; tm < 2; ++tm)
#pragma unroll
        for (int tn = 0; tn < 2; ++tn)
#pragma unroll
          for (int i = 0; i < 8; ++i) {
            const float p0 = bflo(gp[tm][tn][i]) * va[tm][tn][2 * i], p1 = bfhi(gp[tm][tn][i]) * va[tm][tn][2 * i + 1];
            if (br == 0) resp[tm][tn][i] = pack2(p0, p1);
            else { va[tm][tn][2 * i] = bflo(resp[tm][tn][i]) + p0; va[tm][tn][2 * i + 1] = bfhi(resp[tm][tn][i]) + p1; }
          }
    }
    gemm_epi_rows<2, 2>(va, smem, [&](int m, int n, f32x4 v) {
      u32x2 o = {pack2(v[0], v[1]), pack2(v[2], v[3])};
      *(u32x2*)(merged + (size_t)(m0 + m) * DM + n0 + n) = o;
    });
  }
}
DI void phase_outproj(const Params& P, unsigned char* smem) {
  pg8::Gemm g{(const pg8::bf16_t*)(P.ws + R_MERGED), (const pg8::bf16_t*)(P.ws + WS_WOUT), T, DM, DM};
  pg8::StaticOrder S; S.init(T, DM, (int)gridDim.x, (int)blockIdx.x);
  EpiResF32 E{P.out, P.in[0]};
  pg8::gemm_phase<EpiResF32, pg8::StaticOrder, false>((PG8_LAS unsigned char*)smem, g, S, E, nullptr);
  __syncthreads();
}
DI float wave_sum(float v) {
#pragma unroll
  for (int off = 32; off >= 1; off >>= 1) v += __shfl_xor(v, off);
  return v;
}
DI void phase_ln1(const Params& P) {
  const int tid = threadIdx.x, lane = tid & 63, w = tid >> 6;
  const float* gam = P.in[17]; const float* bet = P.in[18];
  bf16_t* hb = (bf16_t*)(P.ws + WS_XB);
  for (int row = blockIdx.x * 8 + w; row < T; row += gridDim.x * 8) {
    const float* r = P.out + (size_t)row * DM;
    f32x4 v[4];
    v[0] = *(const f32x4*)(r + lane * 8); v[1] = *(const f32x4*)(r + lane * 8 + 4); v[2] = *(const f32x4*)(r + 512 + lane * 8); v[3] = *(const f32x4*)(r + 512 + lane * 8 + 4);
    float s = 0.f;
#pragma unroll
    for (int i = 0; i < 4; ++i) s += v[i][0] + v[i][1] + v[i][2] + v[i][3];
    const float mu = wave_sum(s) * (1.f / 1024.f);
    float ss = 0.f;
#pragma unroll
    for (int i = 0; i < 4; ++i)
#pragma unroll
      for (int k = 0; k < 4; ++k) { const float d = v[i][k] - mu; ss += d * d; }
    const float rs = rsqrtf(wave_sum(ss) * (1.f / 1024.f) + 1.0e-5f);
#pragma unroll
    for (int i = 0; i < 4; ++i) {
      const int c = (i >> 1) * 512 + lane * 8 + (i & 1) * 4;
      const f32x4 gg = *(const f32x4*)(gam + c), bb = *(const f32x4*)(bet + c);
#pragma unroll
      for (int k = 0; k < 4; ++k) v[i][k] = (v[i][k] - mu) * rs * gg[k] + bb[k];
    }
    *(u32x4*)(hb + (size_t)row * DM + lane * 8) = cvt8(v[0], v[1]);
    *(u32x4*)(hb + (size_t)row * DM + 512 + lane * 8) = cvt8(v[2], v[3]);
  }
}

DI void fp8_conv_item(const Params& P, int item) {
  const int tid = threadIdx.x, lane = tid & 63, w = tid >> 6;
  for (int rr_ = 0; rr_ < 8; ++rr_) {
    const int row = item * 64 + w * 8 + rr_;
    const int which = row >> 14, rr = row & 16383;
    const float* sp = P.in[22 + which] + (size_t)rr * DM + lane * 16;
    f32x4 a[4];
#pragma unroll
    for (int i = 0; i < 4; ++i) a[i] = *(const f32x4*)(sp + i * 4);
    float mx = 0.f;
#pragma unroll
    for (int i = 0; i < 4; ++i)
#pragma unroll
      for (int k = 0; k < 4; ++k) mx = fmaxf(mx, fabsf(a[i][k]));
#pragma unroll
    for (int off = 32; off >= 1; off >>= 1) mx = fmaxf(mx, __shfl_xor(mx, off));
    const float sc = mx > 0.f ? 256.f / mx : 1.f;
    u32x4 o;
#pragma unroll
    for (int i = 0; i < 4; ++i) {
      int wd = 0;
      wd = __builtin_amdgcn_cvt_pk_fp8_f32(a[i][0] * sc, a[i][1] * sc, wd, false);
      wd = __builtin_amdgcn_cvt_pk_fp8_f32(a[i][2] * sc, a[i][3] * sc, wd, true);
      o[i] = (unsigned)wd;
    }
    *(u32x4*)(P.ws + (which ? R_VB8 : R_UB8) + (size_t)rr * 1024 + lane * 16) = o;
    if (lane == 0) ((float*)(P.ws + R_USC))[row] = mx > 0.f ? mx * (1.f / 256.f) : 1.f;
  }
}

DI void bubble16(float (&tv)[16], float v) {
#pragma unroll
  for (int k = 0; k < 16; ++k) { const float hi = fmaxf(tv[k], v); v = fminf(tv[k], v); tv[k] = hi; }
}
DI void ce_desc(float& a, float& b) { const float hi = fmaxf(a, b), lo = fminf(a, b); a = hi; b = lo; }
DI void bitonic_merge16_desc(float (&v)[16]) {
#pragma unroll
  for (int j = 8; j > 0; j >>= 1)
#pragma unroll
    for (int i = 0; i < 16; ++i) { const int l = i ^ j; if (l > i) ce_desc(v[i], v[l]); }
}
DI void sort16_desc(float (&v)[16]) {
#pragma unroll
  for (int k = 2; k <= 16; k <<= 1)
#pragma unroll
    for (int j = k >> 1; j > 0; j >>= 1)
#pragma unroll
      for (int i = 0; i < 16; ++i) { const int l = i ^ j; if (l > i) { if ((i & k) == 0) ce_desc(v[i], v[l]); else ce_desc(v[l], v[i]); } }
}
DI void merge_top16(float (&tv)[16], const float (&nv)[16]) {
#pragma unroll
  for (int i = 0; i < 16; ++i) tv[i] = fmaxf(tv[i], nv[15 - i]);
  bitonic_merge16_desc(tv);
}
DI void phase_route(const Params& P, unsigned char* smem) {
  const int tid = threadIdx.x, lane = tid & 63, w = tid >> 6, l32 = lane & 31, h = lane >> 5;
  const bf16_t* hb = (const bf16_t*)(P.ws + WS_XB);
  const bf16_t* wq = (const bf16_t*)(P.ws + WS_WQ);
  u32x2* rec = (u32x2*)(P.ws + R_EID);
  unsigned char* idxb = smem + 110592 + tid * 32;
  for (int tile = blockIdx.x; tile < 64 * 8; tile += gridDim.x) {
    const int mt = tile >> 3, hd = tile & 7, m0 = mt * 256;
    float top[2][16];
#pragma unroll
    for (int half = 0; half < 2; ++half) {
      const int n0 = hd * 256 + half * 128;
      f32x16 acc[2][2]; zero_acc(acc);
      gemm_kloop<2, 2>(acc, 16,
        [&](int r, int ko, int kt) { return ldg16(hb + (size_t)(m0 + r) * DM + kt * 64 + ko); },
        [&](int r, int ko, int kt) { return ldg16(wq + (size_t)(n0 + r) * DM + kt * 64 + ko); }, smem);
      gemm_epi<2, 2>(acc, [&](int m, int n, float v0, float v1, float v2, float v3) {
        bf16_t* d = (bf16_t*)smem + m * 136 + n;
        d[0] = f2bf(v0); d[136] = f2bf(v1); d[272] = f2bf(v2); d[408] = f2bf(v3);
      });
      {
        const bf16_t* sk = (const bf16_t*)(P.ws + (half ? SM_SK2 : SM_SK1));
#pragma unroll
        for (int i = 0; i < 4; ++i) {
          const int c = tid + i * NTHR;
          *(u32x4*)(smem + 69632 + (c >> 4) * 272 + (c & 15) * 16) = ldg16(sk + (c >> 4) * 128 + (c & 15) * 8);
        }
      }
      __syncthreads();
      float tv[16];
#pragma unroll
      for (int k = 0; k < 16; ++k) tv[k] = -3.0e38f;
#pragma unroll 1
      for (int ktp = 0; ktp < 2; ++ktp) {
        f32x16 st[2]; st[0] = zero16(); st[1] = zero16();
#pragma unroll 2
        for (int ks = 0; ks < 8; ++ks) {
          const bf16x8 qf = *(const bf16x8*)(smem + (w * 32 + l32) * 272 + (ks * 2 + h) * 16);
#pragma unroll
          for (int kk = 0; kk < 2; ++kk) {
            const bf16x8 a = *(const bf16x8*)(smem + 69632 + ((ktp * 2 + kk) * 32 + l32) * 272 + (ks * 2 + h) * 16);
            st[kk] = MFMA(a, qf, st[kk]);
          }
        }
#pragma unroll
        for (int kk = 0; kk < 2; ++kk) {
          float gsort[16];
#pragma unroll
          for (int i = 0; i < 16; ++i) {
            const unsigned key = (unsigned)((ktp * 2 + kk) * 32 + crow(i, h));
            gsort[i] = __uint_as_float((__float_as_uint(st[kk][i]) & ~127u) | key);
          }
          sort16_desc(gsort);
          merge_top16(tv, gsort);
        }
      }
      float pv[16];
#pragma unroll
      for (int k = 0; k < 16; ++k) pv[k] = __shfl_xor(tv[k], 32);
      merge_top16(tv, pv);
#pragma unroll
      for (int k = 0; k < 16; ++k) top[half][k] = tv[k];
    }
#pragma unroll
    for (int k = 0; k < 16; ++k) { idxb[k] = (unsigned char)(__float_as_uint(top[0][k]) & 127u); idxb[16 + k] = (unsigned char)(__float_as_uint(top[1][k]) & 127u); }
    float tv[16];
#pragma unroll
    for (int k = 0; k < 16; ++k) tv[k] = -3.0e38f;
#pragma unroll
    for (int a = 0; a < 16; ++a)
#pragma unroll
      for (int bb = 0; bb < 16; ++bb)
        if ((a + 1) * (bb + 1) <= 16) {
          const float sum = __uint_as_float(__float_as_uint(top[0][a]) & ~127u) + __uint_as_float(__float_as_uint(top[1][bb]) & ~127u);
          bubble16(tv, __uint_as_float((__float_as_uint(sum) & ~255u) | (unsigned)(a * 16 + bb)));
        }
    float e[16], es = 0.f;
    const float mx = __uint_as_float(__float_as_uint(tv[0]) & ~255u);
#pragma unroll
    for (int k = 0; k < 16; ++k) { e[k] = __expf(__uint_as_float(__float_as_uint(tv[k]) & ~255u) - mx); es += e[k]; }
    const float inv = 1.f / es;
    if (h == 0) {
      const size_t base = ((size_t)(m0 + w * 32 + l32) * 8 + hd) * 16;
#pragma unroll
      for (int k = 0; k < 16; ++k) {
        const unsigned code = __float_as_uint(tv[k]) & 255u;
        u32x2 rc = {(unsigned)idxb[code >> 4] * 128u + (unsigned)idxb[16 + (code & 15)], __float_as_uint(e[k] * inv)};
        rec[base + k] = rc;
      }
    }
    __syncthreads();
  }
}

template <int TK>
DI void gather_batch(const unsigned char* ub, const unsigned char* vb, const float* usc, const float* vsc, const u32x2* srt,
                     int base, int n, const f32x2 (&x)[8], f32x2 (&acc)[8], int lane, int sub, bool b5, bool b4, bool b3) {
#pragma unroll 1
  for (int i = 0; i < n; i += 8) {
    const bool valid = (i + sub) < n;
    const u32x2 rc = srt[base + (valid ? i + sub : i)];
    const int my_e = (int)rc[0];
    const float gate = valid ? __uint_as_float(rc[1]) : 0.f;
    u32x4 ur[8], vr[8];
#pragma unroll
    for (int e = 0; e < 8; ++e) {
      const int id = __builtin_amdgcn_readlane(my_e, 8 * e);
      ur[e] = *(const u32x4*)(ub + (size_t)id * 1024 + lane * 16);
    }
#pragma unroll
    for (int e = 0; e < 8; ++e) {
      const int id = __builtin_amdgcn_readlane(my_e, 8 * e);
      vr[e] = *(const u32x4*)(vb + (size_t)id * 1024 + lane * 16);
    }
    const float su = usc[my_e], sv = vsc[my_e];
    float d[8];
#pragma unroll
    for (int e = 0; e < 8; ++e) {
      f32x2 sacc = f32x2{0.f, 0.f};
#pragma unroll
      for (int k = 0; k < 4; ++k) {
        sacc = __builtin_elementwise_fma(__builtin_amdgcn_cvt_pk_f32_fp8((int)ur[e][k], false), x[2 * k], sacc);
        sacc = __builtin_elementwise_fma(__builtin_amdgcn_cvt_pk_f32_fp8((int)ur[e][k], true), x[2 * k + 1], sacc);
      }
      d[e] = sacc[0] + sacc[1];
    }
    float r4[4], r2[2];
#pragma unroll
    for (int k = 0; k < 4; ++k) { const float keep = b5 ? d[k + 4] : d[k], send = b5 ? d[k] : d[k + 4]; r4[k] = keep + __shfl_xor(send, 32); }
#pragma unroll
    for (int k = 0; k < 2; ++k) { const float keep = b4 ? r4[k + 2] : r4[k], send = b4 ? r4[k] : r4[k + 2]; r2[k] = keep + __shfl_xor(send, 16); }
    float r1;
    { const float keep = b3 ? r2[1] : r2[0], send = b3 ? r2[0] : r2[1]; r1 = keep + __shfl_xor(send, 8); }
    r1 += __shfl_xor(r1, 4); r1 += __shfl_xor(r1, 2); r1 += __shfl_xor(r1, 1);
    const float wv = gate * geluf_(r1 * su) * sv;
#pragma unroll
    for (int e = 0; e < 8; ++e) {
      const float wt = __builtin_bit_cast(float, __builtin_amdgcn_readlane(__builtin_bit_cast(int, wv), 8 * e));
      const f32x2 w2 = f32x2{wt, wt};
#pragma unroll
      for (int k = 0; k < 4; ++k) {
        acc[2 * k] = __builtin_elementwise_fma(__builtin_amdgcn_cvt_pk_f32_fp8((int)vr[e][k], false), w2, acc[2 * k]);
        acc[2 * k + 1] = __builtin_elementwise_fma(__builtin_amdgcn_cvt_pk_f32_fp8((int)vr[e][k], true), w2, acc[2 * k + 1]);
      }
    }
  }
}
DI void phase_gather(const Params& P, unsigned char* smem) {
  const int tid = threadIdx.x, lane = tid & 63, w = __builtin_amdgcn_readfirstlane(tid >> 6);
  const unsigned char* ub = P.ws + R_UB8;
  const unsigned char* vb = P.ws + R_VB8;
  const float* usc = (const float*)(P.ws + R_USC);
  const float* vsc = (const float*)(P.ws + R_VSC);
  const float* gam = P.in[24]; const float* bet = P.in[25];
  bf16_t* hb = (bf16_t*)(P.ws + WS_XB);
  const int sub = (lane >> 3) & 7;
  const bool b5 = (lane & 32) != 0, b4 = (lane & 16) != 0, b3 = (lane & 8) != 0;
  unsigned char* wbase = smem + w * 5120;
  u32x2* srt = (u32x2*)wbase;
  int* cnt = (int*)(wbase + 4096);
  int* off = (int*)(wbase + 4096 + 256);
  int* cur = (int*)(wbase + 4096 + 512);
  __syncthreads();
  for (int grp = blockIdx.x * 8 + w; grp < T / 4; grp += gridDim.x * 8) {
    const int tok0 = grp * 4;
    f32x2 x[4][8], acc[4][8];
#pragma unroll
    for (int tk = 0; tk < 4; ++tk) {
      const u32x2* rec = (const u32x2*)(P.ws + R_EID) + (size_t)(tok0 + tk) * 128;
      const u32x2 r0 = rec[lane], r1 = rec[64 + lane];
      if (lane < 16) cnt[tk * 16 + lane] = 0;
      const int c0 = (int)(r0[0] >> 11), c1 = (int)(r1[0] >> 11);
      atomicAdd(&cnt[tk * 16 + c0], 1); atomicAdd(&cnt[tk * 16 + c1], 1);
      if (lane < 16) {
        int sacc = 0;
        for (int j = 0; j < 16; ++j) sacc += (j < lane) ? cnt[tk * 16 + j] : 0;
        off[tk * 16 + lane] = sacc; cur[tk * 16 + lane] = sacc;
      }
      const int p0 = atomicAdd(&cur[tk * 16 + c0], 1);
      srt[tk * 128 + p0] = r0;
      const int p1 = atomicAdd(&cur[tk * 16 + c1], 1);
      srt[tk * 128 + p1] = r1;
      const float* rin = P.out + (size_t)(tok0 + tk) * DM + lane * 16;
      {
        f32x4 a[4];
#pragma unroll
        for (int i = 0; i < 4; ++i) a[i] = *(const f32x4*)(rin + i * 4);
        float s1 = 0.f;
#pragma unroll
        for (int i = 0; i < 4; ++i) s1 += a[i][0] + a[i][1] + a[i][2] + a[i][3];
        const float mu1 = wave_sum(s1) * (1.f / 1024.f);
        float s2 = 0.f;
#pragma unroll
        for (int i = 0; i < 4; ++i)
#pragma unroll
          for (int k = 0; k < 4; ++k) { const float dd = a[i][k] - mu1; s2 += dd * dd; }
        const float rs1 = rsqrtf(wave_sum(s2) * (1.f / 1024.f) + 1.0e-5f);
#pragma unroll
        for (int i = 0; i < 4; ++i) {
          const f32x4 gg = *(const f32x4*)(P.in[17] + lane * 16 + i * 4), bb = *(const f32x4*)(P.in[18] + lane * 16 + i * 4);
#pragma unroll
          for (int k = 0; k < 4; ++k) a[i][k] = (a[i][k] - mu1) * rs1 * gg[k] + bb[k];
          x[tk][2 * i] = f32x2{a[i][0], a[i][1]}; x[tk][2 * i + 1] = f32x2{a[i][2], a[i][3]};
        }
      }
#pragma unroll
      for (int k = 0; k < 8; ++k) acc[tk][k] = f32x2{0.f, 0.f};
    }
    __builtin_amdgcn_s_waitcnt(0xc07f);
#pragma unroll 1
    for (int c = 0; c < 8; ++c) {
#pragma unroll
      for (int tk = 0; tk < 4; ++tk) {
        const int n = __builtin_amdgcn_readfirstlane(cnt[tk * 16 + c]);
        const int base = __builtin_amdgcn_readfirstlane(off[tk * 16 + c]);
        gather_batch<0>(ub, vb, usc, vsc, srt + tk * 128, base, n, x[tk], acc[tk], lane, sub, b5, b4, b3);
      }
    }
#pragma unroll
    for (int tk = 0; tk < 4; ++tk) {
      float* r = P.out + (size_t)(tok0 + tk) * DM + lane * 16;
      float y[16];
      float s = 0.f;
#pragma unroll
      for (int k = 0; k < 8; ++k) { y[2 * k] = acc[tk][k][0] + LN_ALPHA * x[tk][k][0]; y[2 * k + 1] = acc[tk][k][1] + LN_ALPHA * x[tk][k][1]; s += y[2 * k] + y[2 * k + 1]; }
      const float mu = wave_sum(s) * (1.f / 1024.f);
      float ss = 0.f;
#pragma unroll
      for (int k = 0; k < 16; ++k) { const float dd = y[k] - mu; ss += dd * dd; }
      const float rs = rsqrtf(wave_sum(ss) * (1.f / 1024.f) + 1.0e-5f);
      f32x4 o[4];
#pragma unroll
      for (int i = 0; i < 4; ++i) {
        const int cc = lane * 16 + i * 4;
        const f32x4 gg = *(const f32x4*)(gam + cc), bb = *(const f32x4*)(bet + cc);
#pragma unroll
        for (int k = 0; k < 4; ++k) o[i][k] = (y[i * 4 + k] - mu) * rs * gg[k] + bb[k];
        *(f32x4*)(r + i * 4) = o[i];
      }
      *(u32x4*)(hb + (size_t)(tok0 + tk) * DM + lane * 16) = cvt8(o[0], o[1]);
      *(u32x4*)(hb + (size_t)(tok0 + tk) * DM + lane * 16 + 8) = cvt8(o[2], o[3]);
    }
  }
}

DI void phase_final(const Params& P, unsigned char* smem, const bool dry) {
  const bf16_t* hb = (const bf16_t*)(P.ws + WS_XB);
  const bf16_t* wpg = (const bf16_t*)(P.ws + WS_WPG);
  const bf16_t* wpp = (const bf16_t*)(P.ws + WS_WPP);
  const float* pp = P.in[1];
  for (int tile = blockIdx.x; tile < 64 * 8; tile += gridDim.x) {
    const int mt = tile >> 3, nt = tile & 7, m0 = mt * 256, n0 = nt * 128;
    f32x16 ag[2][2], ap[2][2]; zero_acc(ag); zero_acc(ap);
    gemm_kloop<2, 2>(ag, 16,
      [&](int r, int ko, int kt) { return ldg16(hb + (size_t)(m0 + r) * DM + kt * 64 + ko); },
      [&](int r, int ko, int kt) { return ldg16(wpg + (size_t)(n0 + r) * DM + kt * 64 + ko); }, smem);
    gemm_kloop<2, 2>(ap, 4,
      [&](int r, int ko, int kt) { const float* s = pp + (size_t)(m0 + r) * 256 + kt * 64 + ko; return cvt8(*(const f32x4*)s, *(const f32x4*)(s + 4)); },
      [&](int r, int ko, int kt) { return ldg16(wpp + (size_t)(n0 + r) * 256 + kt * 64 + ko); }, smem);
#pragma unroll
    for (int tm = 0; tm < 2; ++tm)
#pragma unroll
      for (int tn = 0; tn < 2; ++tn)
#pragma unroll
        for (int i = 0; i < 16; ++i) ag[tm][tn][i] = sigmoidf_(ag[tm][tn][i]) * ap[tm][tn][i];
    gemm_epi_rows<2, 2>(ag, smem, [&](int m, int n, f32x4 v) {
      const size_t o = (size_t)(m0 + m) * DM + n0 + n;
      const f32x4 hv = *(const f32x4*)(P.out + o);
      float* dst = dry ? (float*)(P.ws + WS_R + 32 * MiB) : P.out;
      *(f32x4*)(dst + o) = hv + v;
    });
  }
}

#define XB_TMO      128
#define XB_XCNT(j)  (256  + 64 * (j))
#define XB_XSUB(j)  (1280 + 64 * (j))
#define XB_XGEN(j)  (2304 + 64 * (j))
#define XB_TOP      3328
#define XB_TOPGEN   3392
#define XCD_BAR_WORDS 3456
#define XB_SPIN_CAP (1u << 18)
#define LAS __attribute__((address_space(3)))

__device__ __forceinline__ unsigned xb_ld(unsigned* p)              { return __hip_atomic_load(p, __ATOMIC_RELAXED, __HIP_MEMORY_SCOPE_AGENT); }
__device__ __forceinline__ unsigned xb_add(unsigned* p, unsigned v) { return __hip_atomic_fetch_add(p, v, __ATOMIC_RELAXED, __HIP_MEMORY_SCOPE_AGENT); }
__device__ __forceinline__ unsigned xb_xcc_id() { return (unsigned)__builtin_amdgcn_s_getreg((3 << 11) | 20) & 0xFu; }
#define XB_SPIN(cond, bar) do { unsigned _sp = 0; while (cond) { __builtin_amdgcn_s_sleep(1); \
    if ((++_sp & 255u) == 0u) { if (xb_ld(&(bar)[XB_TMO])) break; if (_sp > XB_SPIN_CAP) { atomicAdd(&(bar)[XB_TMO], 1u); break; } } } } while (0)

struct XcdBarrier {
    unsigned* bar; unsigned x;
    volatile LAS unsigned* st;
};

__device__ __forceinline__ XcdBarrier xcd_barrier_post(unsigned* bar, volatile LAS unsigned* st) {
    XcdBarrier b; b.bar = bar; b.x = xb_xcc_id(); b.st = st;
    if (threadIdx.x == 0) (void)xb_add(&bar[XB_XCNT(b.x)], 1u);
    return b;
}
__device__ __forceinline__ void xcd_barrier_complete(unsigned* bar, unsigned x, unsigned& nloc, unsigned& nx) {
    const unsigned G = gridDim.x * gridDim.y * gridDim.z;
    unsigned sum, cnt, mine, sp = 0u;
    for (;;) {
        sum = 0u; cnt = 0u; mine = 0u;
#pragma unroll
        for (unsigned j = 0; j < 16; ++j) { const unsigned c = xb_ld(&bar[XB_XCNT(j)]); sum += c; cnt += (c > 0u) ? 1u : 0u; mine = (j == x) ? c : mine; }
        if (sum == G) break;
        __builtin_amdgcn_s_sleep(1);
        if ((++sp & 255u) == 0u) { if (xb_ld(&bar[XB_TMO])) break; if (sp > XB_SPIN_CAP) { atomicAdd(&bar[XB_TMO], 1u); break; } }
    }
    nloc = mine > 0u ? mine : 1u; nx = cnt > 0u ? cnt : 1u;
}

__device__ __forceinline__ void xcd_barrier(const XcdBarrier& b) {
    asm volatile("s_waitcnt vmcnt(0)" ::: "memory");
    __syncthreads();
    if (threadIdx.x == 0) {
        unsigned* bar = b.bar;
        __builtin_amdgcn_s_waitcnt(0);
        unsigned nloc = b.st[0], nx = b.st[1];
        if (nloc == 0u) { xcd_barrier_complete(bar, b.x, nloc, nx); b.st[0] = nloc; b.st[1] = nx; }
        const unsigned old = xb_add(&bar[XB_XSUB(b.x)], 1u);
        const unsigned gen = old / nloc;
        if (old + 1u == (gen + 1u) * nloc) {
            __builtin_amdgcn_fence(__ATOMIC_RELEASE, "agent");
            asm volatile("s_waitcnt vmcnt(0)" ::: "memory");
            const unsigned og = xb_add(&bar[XB_TOP], 1u);
            const unsigned tg = og / nx;
            if (og + 1u == (tg + 1u) * nx) xb_add(&bar[XB_TOPGEN], 1u);
            else XB_SPIN(xb_ld(&bar[XB_TOPGEN]) == tg, bar);
            __builtin_amdgcn_fence(__ATOMIC_ACQUIRE, "agent");
            xb_add(&bar[XB_XGEN(b.x)], 1u);
            asm volatile("s_waitcnt vmcnt(0)" ::: "memory");
        } else {
            XB_SPIN(xb_ld(&bar[XB_XGEN(b.x)]) == gen, bar);
            __builtin_amdgcn_fence(__ATOMIC_ACQUIRE, "agent");
            asm volatile("s_waitcnt vmcnt(0)" ::: "memory");
        }
    }
    __syncthreads();
}


DI void grid_barrier(unsigned* ctr, unsigned target) {
  asm volatile("s_waitcnt vmcnt(0)" ::: "memory");
  __syncthreads();
  if (threadIdx.x == 0) {
    __builtin_amdgcn_fence(__ATOMIC_RELEASE, "agent");
    asm volatile("s_waitcnt vmcnt(0)" ::: "memory");
    __hip_atomic_fetch_add(ctr, 1u, __ATOMIC_RELAXED, __HIP_MEMORY_SCOPE_AGENT);
    unsigned sp = 0;
    while (__hip_atomic_load(ctr, __ATOMIC_RELAXED, __HIP_MEMORY_SCOPE_AGENT) < target) {
      __builtin_amdgcn_s_sleep(1);
      if (++sp > (1u << 24)) break;
    }
    __builtin_amdgcn_fence(__ATOMIC_ACQUIRE, "agent");
    asm volatile("s_waitcnt vmcnt(0)" ::: "memory");
  }
  __syncthreads();
}

__global__ void __launch_bounds__(NTHR) mk_fwd(Params P) {
  extern __shared__ __attribute__((aligned(16))) unsigned char smem[];
  cg::grid_group grid = cg::this_grid();
  unsigned* bar_ctr = (unsigned*)(P.ws + SM_BAR);
  if (P.ph_lo > 1000) grid.sync();
  XcdBarrier xb;
  {
    volatile LAS unsigned* stw = (volatile LAS unsigned*)(smem + LDS_GEMM);
    if (threadIdx.x == 0) { stw[0] = 0u; stw[1] = 0u; stw[2] = 0u; stw[3] = 0u; }
    __syncthreads();
    if (P.ph_hi - P.ph_lo > 1) xb = xcd_barrier_post(bar_ctr, stw);
    else { xb.bar = bar_ctr; xb.x = 0; xb.st = stw; }
  }
  if ((PHASE_MASK & (1 << 0)) && P.ph_lo <= 0 && 0 < P.ph_hi) {
    if (P.ph_lo < 0) xcd_barrier(xb);
    for (int rep = 0; rep < (((REPEAT_MASK >> 0) & 1) ? 2 : 1); ++rep) phase_prep(P, smem);
    asm volatile("" ::: "memory");
  }
  if ((PHASE_MASK & (1 << 1)) && P.ph_lo <= 1 && 1 < P.ph_hi) {
    if (P.ph_lo < 1) xcd_barrier(xb);
    for (int rep = 0; rep < (((REPEAT_MASK >> 1) & 1) ? 2 : 1); ++rep) phase_inproj(P, smem);
    asm volatile("" ::: "memory");
  }
  if ((PHASE_MASK & (1 << 2)) && P.ph_lo <= 2 && 2 < P.ph_hi) {
    if (P.ph_lo < 2) xcd_barrier(xb);
    phase_queue(P, smem, bar_ctr + 8, (P.ph_hi - P.ph_lo) > 1);
    asm volatile("" ::: "memory");
  }
  if ((PHASE_MASK & (1 << 3)) && P.ph_lo <= 3 && 3 < P.ph_hi && (P.ph_hi - P.ph_lo) <= 1) {
    if (P.ph_lo < 3) xcd_barrier(xb);
    for (int rep = 0; rep < (((REPEAT_MASK >> 3) & 1) ? 2 : 1); ++rep) phase_cmp2(P, smem);
    asm volatile("" ::: "memory");
  }
  if ((PHASE_MASK & (1 << 4)) && P.ph_lo <= 4 && 4 < P.ph_hi) {
    if (P.ph_lo < 4) xcd_barrier(xb);
    phase_nsa(P, smem, bar_ctr + 9, (P.ph_hi - P.ph_lo) > 1);
    asm volatile("" ::: "memory");
  }
  if ((PHASE_MASK & (1 << 5)) && P.ph_lo <= 5 && 5 < P.ph_hi) {
    if (P.ph_lo < 5) xcd_barrier(xb);
    for (int rep = 0; rep < (((REPEAT_MASK >> 5) & 1) ? 2 : 1); ++rep) phase_merge(P, smem);
    asm volatile("" ::: "memory");
  }
  if ((PHASE_MASK & (1 << 6)) && P.ph_lo <= 6 && 6 < P.ph_hi) {
    if (P.ph_lo < 6) xcd_barrier(xb);
    for (int rep = 0; rep < (((REPEAT_MASK >> 6) & 1) ? 2 : 1); ++rep) phase_outproj(P, smem);
    asm volatile("" ::: "memory");
  }
  if ((PHASE_MASK & (1 << 7)) && P.ph_lo <= 7 && 7 < P.ph_hi) {
    if (P.ph_lo < 7) xcd_barrier(xb);
    for (int rep = 0; rep < (((REPEAT_MASK >> 7) & 1) ? 2 : 1); ++rep) phase_ln1(P);
    asm volatile("" ::: "memory");
  }
  if ((PHASE_MASK & (1 << 8)) && P.ph_lo <= 8 && 8 < P.ph_hi) {
    if (P.ph_lo < 8) xcd_barrier(xb);
    for (int rep = 0; rep < (((REPEAT_MASK >> 8) & 1) ? 2 : 1); ++rep) phase_route(P, smem);
    asm volatile("" ::: "memory");
  }
  if ((PHASE_MASK & (1 << 9)) && P.ph_lo <= 9 && 9 < P.ph_hi) {
    if (P.ph_lo < 9) xcd_barrier(xb);
    for (int rep = 0; rep < (((REPEAT_MASK >> 9) & 1) ? 2 : 1); ++rep) phase_gather(P, smem);
    asm volatile("" ::: "memory");
  }
  if ((PHASE_MASK & (1 << 10)) && P.ph_lo <= 10 && 10 < P.ph_hi) {
    if (P.ph_lo < 10) xcd_barrier(xb);
    for (int rep = 0; rep < (((REPEAT_MASK >> 10) & 1) ? 2 : 1); ++rep) phase_final(P, smem, (((REPEAT_MASK >> 10) & 1) != 0) && rep == 0);
    for (int xs = 0; xs < EXTRA_SYNCS; ++xs) xcd_barrier(xb);
    asm volatile("" ::: "memory");
  }
}

static void add_job(Params& p, const float* src, size_t dst_off, int ld, int col0, int ncols, int npad, int K) {
  TJob& j = p.jobs[p.njobs++];
  j.src = src; j.dst = (bf16_t*)(p.ws + dst_off); j.ld = ld; j.col0 = col0; j.ncols = ncols; j.npad = npad; j.K = K; j.tile0 = p.ntiles_t;
  p.ntiles_t += (npad / 64) * (K / 64);
}

extern "C" void kernel_launch(void* const* d_in, const int* in_sizes, int n_in, void* d_out, int out_size, void* d_ws, size_t ws_size, hipStream_t stream) {
  static int grid = 0;
  if (grid == 0) {
    int dev = 0, cus = 0, per_cu = 0;
    hipGetDevice(&dev);
    hipDeviceGetAttribute(&cus, hipDeviceAttributeMultiprocessorCount, dev);
    hipFuncSetAttribute((const void*)mk_fwd, hipFuncAttributeMaxDynamicSharedMemorySize, LDS_BYTES);
    hipOccupancyMaxActiveBlocksPerMultiprocessor(&per_cu, (const void*)mk_fwd, NTHR, LDS_BYTES);
    if (per_cu < 1) { fprintf(stderr, "occupancy query returned %d\n", per_cu); per_cu = 1; }
    grid = cus * per_cu;
    (void)hipGetLastError();
  }
  Params p;
  memset(&p, 0, sizeof(p));
  for (int i = 0; i < 28; ++i) p.in[i] = (const float*)d_in[i];
  p.out = (float*)d_out; p.ws = (unsigned char*)d_ws;
  const float* w_in = p.in[2];
  const size_t e2 = 2;
  add_job(p, w_in, WS_WINR + e2 * 0 * 1024, 4888, 0, 512, 512, 1024);
  add_job(p, w_in, WS_WINR + e2 * 512 * 1024, 4888, 512, 128, 128, 1024);
  add_job(p, w_in, WS_WINR + e2 * 640 * 1024, 4888, 768, 128, 128, 1024);
  add_job(p, w_in, WS_WINR + e2 * 768 * 1024, 4888, 1024, 128, 128, 1024);
  add_job(p, w_in, WS_WINR + e2 * 896 * 1024, 4888, 640, 128, 128, 1024);
  add_job(p, w_in, WS_WINR + e2 * 1024 * 1024, 4888, 1304, 512, 512, 1024);
  add_job(p, w_in, WS_WINR + e2 * 1536 * 1024, 4888, 1816, 512, 512, 1024);
  add_job(p, w_in, WS_WINR + e2 * 2048 * 1024, 4888, 1280, 24, 128, 1024);
  add_job(p, w_in, WS_WINR + e2 * 2176 * 1024, 4888, 896, 128, 128, 1024);
  add_job(p, w_in, WS_WINR + e2 * 2304 * 1024, 4888, 1152, 128, 128, 1024);
  add_job(p, w_in, WS_WINR + e2 * 2432 * 1024, 4888, 2328, 512, 512, 1024);
  add_job(p, p.in[5], WS_CW1K, 256, 0, 256, 256, 2048);
  add_job(p, p.in[7], WS_CW1V, 256, 0, 256, 256, 2048);
  add_job(p, p.in[6], SM_CW2K, 64, 0, 64, 64, 256);
  add_job(p, p.in[8], SM_CW2V, 64, 0, 64, 64, 256);
  p.ntiles_early = p.ntiles_t;
  add_job(p, w_in, WS_WGATE, 4888, 2840, 2048, 2048, 1024);
  add_job(p, p.in[14], WS_WBN, 1024, 0, 1024, 1024, 512);
  add_job(p, p.in[15], WS_WBD, 1024, 0, 1024, 1024, 512);
  add_job(p, p.in[16], WS_WOUT, 1024, 0, 1024, 1024, 1024);
  add_job(p, p.in[19], WS_WQ, 2048, 0, 2048, 2048, 1024);
  add_job(p, p.in[27], WS_WPG, 1024, 0, 1024, 1024, 1024);
  add_job(p, p.in[26], WS_WPP, 1024, 0, 1024, 1024, 256);
#if MULTI_LAUNCH
  for (int ph = 0; ph < NPHASE; ++ph) {
    p.ph_lo = ph; p.ph_hi = ph + 1;
    hipLaunchKernelGGL(mk_fwd, dim3(grid), dim3(NTHR), LDS_BYTES, stream, p);
  }
#else
  p.ph_lo = 0; p.ph_hi = NPHASE;
  (void)hipMemsetAsync((char*)d_ws + SM_BAR, 0, XCD_BAR_WORDS * 4, stream);
  void* args[] = {&p};
  hipError_t e = hipLaunchCooperativeKernel((const void*)mk_fwd, dim3(grid), dim3(NTHR), args, LDS_BYTES, stream);
  if (e != hipSuccess) fprintf(stderr, "cooperative launch failed: %s (grid %d)\n", hipGetErrorString(e), grid);
#endif
}
```
